# Optimizing an MI355X kernel written in HIP

```python
import math
import jax, jax.numpy as jnp
from jax import lax
import numpy as np

D_MODEL = 1024
BATCH = 2
SEQ = 8192
DEPTH = 2

N_META = 16
D_RNN = 1280
LRU_BLOCKS = 10
LRU_BLOCK = D_RNN // LRU_BLOCKS
CONV_WIDTH = 4
LRU_C = 8.0
N_HEADS = 8
HEAD_DIM = 128
KV_RANK = 256
IDX_HEADS = 8
IDX_DIM = 64
TOPK_MAX = 256
Q_BLOCK = 128
D_FF = 4 * D_MODEL
DEEPNORM_ALPHA = (2.0 * DEPTH) ** 0.25
DEEPNORM_BETA = (8.0 * DEPTH) ** -0.25
LN_EPS = 1e-5
NEG_INF = -1e30
IN_SPLITS = (D_RNN, D_RNN, N_HEADS * HEAD_DIM, KV_RANK, IDX_HEADS * IDX_DIM, IDX_DIM, IDX_HEADS, D_MODEL, D_MODEL)
D_IN = sum(IN_SPLITS)

kernel_name = "hybrid_rglru_dsa_gated_deepnorm"


def layer_norm(x, g, b):
    xf = x.astype(jnp.float32)
    mu = jnp.mean(xf, axis=-1, keepdims=True)
    var = jnp.mean(jnp.square(xf - mu), axis=-1, keepdims=True)
    return ((xf - mu) * lax.rsqrt(var + LN_EPS) * g.astype(jnp.float32) + b.astype(jnp.float32)).astype(x.dtype)


def unit_layer_norm(x):
    xf = x.astype(jnp.float32)
    mu = jnp.mean(xf, axis=-1, keepdims=True)
    var = jnp.mean(jnp.square(xf - mu), axis=-1, keepdims=True)
    return ((xf - mu) * lax.rsqrt(var + LN_EPS)).astype(x.dtype)


def rms_norm(x, g):
    xf = x.astype(jnp.float32)
    ms = jnp.mean(jnp.square(xf), axis=-1, keepdims=True)
    return (xf * lax.rsqrt(ms + LN_EPS) * g.astype(jnp.float32)).astype(x.dtype)


def split_columns(proj):
    offsets = []
    acc = 0
    for w in IN_SPLITS[:-1]:
        acc += w
        offsets.append(acc)
    return jnp.split(proj, offsets, axis=-1)


def causal_depthwise_conv(x, w, b):
    y = lax.conv_general_dilated(
        x, w[:, None, :], window_strides=(1,), padding=[(CONV_WIDTH - 1, 0)],
        dimension_numbers=('NWC', 'WIO', 'NWC'), feature_group_count=x.shape[-1])
    return y + b


def block_diag_linear(x, w, b):
    B, T, _ = x.shape
    xb = x.reshape(B, T, LRU_BLOCKS, LRU_BLOCK)
    return jnp.einsum('btnc,ncd->btnd', xb, w).reshape(B, T, D_RNN) + b


def rg_lru(x, w_a, b_a, w_x, b_x, lam):
    r = jax.nn.sigmoid(block_diag_linear(x, w_a, b_a)).astype(jnp.float32)
    i = jax.nn.sigmoid(block_diag_linear(x, w_x, b_x)).astype(jnp.float32)
    log_a = -LRU_C * r * jax.nn.softplus(-lam.astype(jnp.float32))
    a = jnp.exp(log_a)
    u = jnp.sqrt(-jnp.expm1(2.0 * log_a)) * (i * x.astype(jnp.float32))

    def combine(left, right):
        a1, b1 = left
        a2, b2 = right
        return a1 * a2, a2 * b1 + b2

    _, h = lax.associative_scan(combine, (a, u), axis=1)
    return h.astype(x.dtype)


def recurrent_branch(x_lru, g_lru, conv_w, conv_b, w_rg_a, b_rg_a, w_rg_x, b_rg_x, lam, w_branch):
    xc = causal_depthwise_conv(x_lru, conv_w, conv_b)
    h = rg_lru(xc, w_rg_a, b_rg_a, w_rg_x, b_rg_x, lam)
    return (h * jax.nn.gelu(g_lru)) @ w_branch


def sparse_attention(q, c_kv, q_idx, k_idx, w_idx, w_uk, w_uv, k_top):
    B, T = q.shape[0], q.shape[1]
    q_abs = jnp.einsum('bthd,hrd->bthr', q, w_uk)
    n_blk = -(-T // Q_BLOCK)
    Tp = n_blk * Q_BLOCK
    pad = Tp - T

    def to_blocks(a):
        a = jnp.pad(a, [(0, 0), (0, pad)] + [(0, 0)] * (a.ndim - 2))
        return jnp.moveaxis(a.reshape((B, n_blk, Q_BLOCK) + a.shape[2:]), 1, 0)

    q_pos = jnp.arange(Tp, dtype=jnp.int32).reshape(n_blk, Q_BLOCK)
    key_pos = jnp.arange(T, dtype=jnp.int32)
    batch_idx = jnp.arange(B, dtype=jnp.int32)[:, None, None]
    scale = HEAD_DIM ** -0.5

    def one_block(args):
        qa, qi, wi, qpos = args
        logits = jnp.einsum('bqhd,bsd->bqhs', qi, k_idx)
        score = jnp.einsum('bqh,bqhs->bqs', wi, jax.nn.relu(logits)).astype(jnp.float32)
        causal = key_pos[None, :] <= qpos[:, None]
        score = jnp.where(causal[None], score, NEG_INF)
        _, idx = lax.top_k(score, k_top)
        valid = idx <= qpos[None, :, None]
        c_sel = c_kv[batch_idx, idx]
        s = jnp.einsum('bqhr,bqkr->bqhk', qa, c_sel).astype(jnp.float32) * scale
        s = jnp.where(valid[:, :, None, :], s, NEG_INF)
        p = jax.nn.softmax(s, axis=-1).astype(c_kv.dtype)
        return jnp.einsum('bqhk,bqkr->bqhr', p, c_sel)

    o_lat = lax.map(one_block, (to_blocks(q_abs), to_blocks(q_idx), to_blocks(w_idx), q_pos))
    o_lat = jnp.moveaxis(o_lat, 0, 1).reshape(B, Tp, N_HEADS, KV_RANK)[:, :T]
    o = jnp.einsum('bthr,hrd->bthd', o_lat, w_uv)
    return o.reshape(B, T, N_HEADS * HEAD_DIM)


def hybrid_layer(x, k_top, w_in, conv_w, conv_b, w_rg_a, b_rg_a, w_rg_x, b_rg_x, lam, kv_norm_g,
                 w_uk, w_uv, w_branch_a, w_branch_b, w_out, ln1_g, ln1_b,
                 w_up, b_up, w_down, b_down, ln2_g, ln2_b):
    B, T, _ = x.shape
    proj = x @ w_in
    x_lru, g_lru, q, c_kv, q_idx, k_idx, w_idx, gate_a, gate_b = split_columns(proj)

    y_a = recurrent_branch(x_lru, g_lru, conv_w, conv_b, w_rg_a, b_rg_a, w_rg_x, b_rg_x, lam, w_branch_a)

    q = q.reshape(B, T, N_HEADS, HEAD_DIM)
    c_kv = rms_norm(c_kv, kv_norm_g)
    q_idx = q_idx.reshape(B, T, IDX_HEADS, IDX_DIM)
    k_idx = unit_layer_norm(k_idx)
    w_idx = w_idx * (IDX_HEADS ** -0.5 * IDX_DIM ** -0.5)
    y_b = sparse_attention(q, c_kv, q_idx, k_idx, w_idx, w_uk, w_uv, k_top) @ w_branch_b

    mixed = jax.nn.sigmoid(gate_a) * y_a + jax.nn.sigmoid(gate_b) * y_b
    x = layer_norm(DEEPNORM_ALPHA * x + mixed @ w_out, ln1_g, ln1_b)

    h = jnp.square(jax.nn.relu(x @ w_up + b_up))
    x = layer_norm(DEEPNORM_ALPHA * x + (h @ w_down + b_down), ln2_g, ln2_b)
    return x


def setup_inputs(seed: int = 0) -> dict:
    key = jax.random.key(seed)
    ks = jax.random.split(key, 32)
    f32 = jnp.float32

    def nrm(k, shape, scale):
        return jax.random.normal(k, shape, f32) * scale

    u = jax.random.uniform(ks[10], (DEPTH, D_RNN), f32, 0.9, 0.999)
    a0 = u ** (1.0 / LRU_C)
    lam = jnp.log(a0) - jnp.log1p(-a0)
    return {
        "x": nrm(ks[0], (BATCH, SEQ, D_MODEL), 1.0),
        "meta_tokens": nrm(ks[1], (N_META, D_MODEL), 1.0),
        "ln_in_g": 1.0 + nrm(ks[2], (D_MODEL,), 0.02),
        "ln_in_b": nrm(ks[3], (D_MODEL,), 0.02),
        "w_in": nrm(ks[4], (DEPTH, D_MODEL, D_IN), D_MODEL ** -0.5),
        "conv_w": nrm(ks[5], (DEPTH, CONV_WIDTH, D_RNN), CONV_WIDTH ** -0.5),
        "conv_b": nrm(ks[6], (DEPTH, D_RNN), 0.02),
        "w_rg_a": nrm(ks[7], (DEPTH, LRU_BLOCKS, LRU_BLOCK, LRU_BLOCK), LRU_BLOCK ** -0.5),
        "b_rg_a": nrm(ks[8], (DEPTH, D_RNN), 0.02),
        "w_rg_x": nrm(ks[9], (DEPTH, LRU_BLOCKS, LRU_BLOCK, LRU_BLOCK), LRU_BLOCK ** -0.5),
        "b_rg_x": nrm(ks[11], (DEPTH, D_RNN), 0.02),
        "lru_lambda": lam,
        "kv_norm_g": 1.0 + nrm(ks[12], (DEPTH, KV_RANK), 0.02),
        "w_uk": nrm(ks[13], (DEPTH, N_HEADS, KV_RANK, HEAD_DIM), KV_RANK ** -0.5),
        "w_uv": nrm(ks[14], (DEPTH, N_HEADS, KV_RANK, HEAD_DIM), KV_RANK ** -0.5),
        "w_branch_a": nrm(ks[15], (DEPTH, D_RNN, D_MODEL), D_RNN ** -0.5),
        "w_branch_b": nrm(ks[16], (DEPTH, N_HEADS * HEAD_DIM, D_MODEL), (N_HEADS * HEAD_DIM) ** -0.5),
        "w_out": nrm(ks[17], (DEPTH, D_MODEL, D_MODEL), D_MODEL ** -0.5 * DEEPNORM_BETA),
        "ln1_g": 1.0 + nrm(ks[18], (DEPTH, D_MODEL), 0.02),
        "ln1_b": nrm(ks[19], (DEPTH, D_MODEL), 0.02),
        "w_up": nrm(ks[20], (DEPTH, D_MODEL, D_FF), D_MODEL ** -0.5),
        "b_up": nrm(ks[21], (DEPTH, D_FF), 0.02),
        "w_down": nrm(ks[22], (DEPTH, D_FF, D_MODEL), D_FF ** -0.5 * DEEPNORM_BETA),
        "b_down": nrm(ks[23], (DEPTH, D_MODEL), 0.02),
        "ln2_g": 1.0 + nrm(ks[24], (DEPTH, D_MODEL), 0.02),
        "ln2_b": nrm(ks[25], (DEPTH, D_MODEL), 0.02),
    }


def reference(x, meta_tokens, ln_in_g, ln_in_b, w_in, conv_w, conv_b, w_rg_a, b_rg_a, w_rg_x, b_rg_x,
              lru_lambda, kv_norm_g, w_uk, w_uv, w_branch_a, w_branch_b, w_out, ln1_g, ln1_b,
              w_up, b_up, w_down, b_down, ln2_g, ln2_b):
    B, S, _ = x.shape
    meta = jnp.broadcast_to(meta_tokens[None].astype(x.dtype), (B, N_META, D_MODEL))
    h = jnp.concatenate([meta, x], axis=1)
    T = S + N_META
    k_top = min(TOPK_MAX, T // 4)
    h = layer_norm(h, ln_in_g, ln_in_b)
    for l in range(DEPTH):
        h = hybrid_layer(h, k_top, w_in[l], conv_w[l], conv_b[l], w_rg_a[l], b_rg_a[l], w_rg_x[l], b_rg_x[l],
                         lru_lambda[l], kv_norm_g[l], w_uk[l], w_uv[l], w_branch_a[l], w_branch_b[l],
                         w_out[l], ln1_g[l], ln1_b[l], w_up[l], b_up[l], w_down[l], b_down[l],
                         ln2_g[l], ln2_b[l])
    return h[:, N_META:]
```

```cpp
#include <hip/hip_runtime.h>
#include <hip/hip_cooperative_groups.h>
#include <cstdint>
#include <cstdio>
namespace cg = cooperative_groups;

#ifndef MK_PER_PHASE
#define MK_PER_PHASE 0
#endif

typedef unsigned short u16;
typedef short s16x8 __attribute__((ext_vector_type(8)));
typedef short s16x4 __attribute__((ext_vector_type(4)));
typedef _Float16 h16x8 __attribute__((ext_vector_type(8)));
typedef _Float16 h16x4 __attribute__((ext_vector_type(4)));
typedef float f32x4 __attribute__((ext_vector_type(4)));
typedef float f32x16 __attribute__((ext_vector_type(16)));
typedef unsigned u32x4 __attribute__((ext_vector_type(4)));
typedef unsigned u32x2 __attribute__((ext_vector_type(2)));

#define DEVI __device__ __forceinline__

constexpr int T_ = 8208, M_ = 16416, MP = 16512, NMT = 129;
constexpr int DIN = 6472;
constexpr float ALPHA = 1.41421356237f;
constexpr float LN_EPS = 1e-5f;
constexpr float ATT_SCALE = 0.08838834764831845f;
constexpr int NPH_LAYER = 13;
constexpr int NPHASES = 1 + 2 * NPH_LAYER;
constexpr int SMEM_BYTES = 69632;

constexpr size_t OFF_W1 = 0;
constexpr size_t OFF_WG = 11272192;
constexpr size_t OFF_WOB = 15466496;
constexpr size_t OFF_WBA = 19660800;
constexpr size_t OFF_WO = 22282240;
constexpr size_t OFF_WUP = 24379392;
constexpr size_t OFF_WDN = 32768000;
constexpr size_t OFF_WRA = 41156608;
constexpr size_t OFF_WRX = 41484288;
constexpr size_t OFF_R1 = 41811968;
constexpr size_t OFF_BIG = 75628544;
constexpr size_t OFF_XL = OFF_BIG + 0;
constexpr size_t OFF_G = OFF_BIG + 42270720;
constexpr size_t OFF_LA = OFF_BIG + 84541440;
constexpr size_t OFF_U = OFF_BIG + 126812160;
constexpr size_t OFF_SUML = OFF_BIG + 169082880;
constexpr size_t OFF_SUMH = OFF_BIG + 170398720;
constexpr size_t OFF_CRAW = OFF_BIG + 0;
constexpr size_t OFF_QI = OFF_BIG + 16908288;
constexpr size_t OFF_CKV = OFF_BIG + 33816576;
constexpr size_t OFF_QA = OFF_BIG + 84541440;
constexpr size_t OFF_KI = OFF_BIG + 152174592;
constexpr size_t OFF_WI = OFF_BIG + 154288128;
constexpr size_t OFF_SEL = OFF_BIG + 154816512;
constexpr size_t OFF_MIX = OFF_BIG + 0;
constexpr size_t OFF_H = OFF_BIG + 0;
constexpr size_t OFF_BAR = OFF_BIG + 171714560;
constexpr size_t WS_NEED = OFF_BAR + 16384;

struct Params {
  const float* in[26];
  float* out;
  unsigned char* ws;
};

typedef const __attribute__((address_space(4))) Params* PP;
DEVI PP kparams() { return (PP)__builtin_amdgcn_kernarg_segment_ptr(); }
__shared__ __attribute__((aligned(16))) unsigned char g_smem[SMEM_BYTES];
#define NOINL __device__ __forceinline__
DEVI int tid_() { int t = threadIdx.x; asm volatile("" : "+v"(t)); return t; }
DEVI int bid_() { int t = blockIdx.x; asm volatile("" : "+s"(t)); return t; }
DEVI int gdim_() { int t = gridDim.x; asm volatile("" : "+s"(t)); return t; }


#define XB_TMO      128
#define XB_XCNT(j)  (256  + 64 * (j))
#define XB_XSUB(j)  (1280 + 64 * (j))
#define XB_XGEN(j)  (2304 + 64 * (j))
#define XB_TOP      3328
#define XB_TOPGEN   3392
#define XCD_BAR_WORDS 3456
#define XB_SPIN_CAP (1u << 20)
#define LAS __attribute__((address_space(3)))
DEVI unsigned xb_ld(unsigned* p) { return __hip_atomic_load(p, __ATOMIC_RELAXED, __HIP_MEMORY_SCOPE_AGENT); }
DEVI unsigned xb_add(unsigned* p, unsigned v) { return __hip_atomic_fetch_add(p, v, __ATOMIC_RELAXED, __HIP_MEMORY_SCOPE_AGENT); }
DEVI unsigned xb_xcc_id() { return (unsigned)__builtin_amdgcn_s_getreg((3 << 11) | 20) & 0xFu; }
#define XB_SPIN(cond, bar) do { unsigned _sp = 0; while (cond) { __builtin_amdgcn_s_sleep(1); \
    if ((++_sp & 255u) == 0u) { if (xb_ld(&(bar)[XB_TMO])) break; if (_sp > XB_SPIN_CAP) { atomicAdd(&(bar)[XB_TMO], 1u); break; } } } } while (0)
struct XcdBarrier { unsigned* bar; unsigned x; volatile LAS unsigned* st; };
DEVI XcdBarrier xcd_barrier_post(unsigned* bar, volatile LAS unsigned* st) {
  XcdBarrier b; b.bar = bar; b.x = xb_xcc_id(); b.st = st;
  if (threadIdx.x == 0) (void)xb_add(&bar[XB_XCNT(b.x)], 1u);
  return b;
}
DEVI void xcd_barrier_complete(unsigned* bar, unsigned x, unsigned& nloc, unsigned& nx) {
  const unsigned G = gridDim.x;
  unsigned sum, cnt, mine, sp = 0u;
  for (;;) {
    sum = 0u; cnt = 0u; mine = 0u;
#pragma unroll
    for (unsigned j = 0; j < 16; ++j) { const unsigned c = xb_ld(&bar[XB_XCNT(j)]); sum += c; cnt += (c > 0u) ? 1u : 0u; mine = (j == x) ? c : mine; }
    if (sum == G) break;
    __builtin_amdgcn_s_sleep(1);
    if ((++sp & 255u) == 0u) { if (xb_ld(&bar[XB_TMO])) break; if (sp > XB_SPIN_CAP) { atomicAdd(&bar[XB_TMO], 1u); break; } }
  }
  nloc = mine > 0u ? mine : 1u; nx = cnt > 0u ? cnt : 1u;
}
DEVI void xcd_barrier(const XcdBarrier& b) {
  asm volatile("s_waitcnt vmcnt(0)" ::: "memory");
  __syncthreads();
  if (threadIdx.x == 0) {
    unsigned* bar = b.bar;
    __builtin_amdgcn_s_waitcnt(0);
    unsigned nloc = b.st[0], nx = b.st[1];
    if (nloc == 0u) { xcd_barrier_complete(bar, b.x, nloc, nx); b.st[0] = nloc; b.st[1] = nx; }
    const unsigned old = xb_add(&bar[XB_XSUB(b.x)], 1u);
    const unsigned gen = old / nloc;
    if (old + 1u == (gen + 1u) * nloc) {
      __builtin_amdgcn_fence(__ATOMIC_RELEASE, "agent");
      asm volatile("s_waitcnt vmcnt(0)" ::: "memory");
      const unsigned og = xb_add(&bar[XB_TOP], 1u);
      const unsigned tg = og / nx;
      if (og + 1u == (tg + 1u) * nx) xb_add(&bar[XB_TOPGEN], 1u);
      else XB_SPIN(xb_ld(&bar[XB_TOPGEN]) == tg, bar);
      __builtin_amdgcn_fence(__ATOMIC_ACQUIRE, "agent");
      xb_add(&bar[XB_XGEN(b.x)], 1u);
      asm volatile("s_waitcnt vmcnt(0)" ::: "memory");
    } else {
      XB_SPIN(xb_ld(&bar[XB_XGEN(b.x)]) == gen, bar);
      __builtin_amdgcn_fence(__ATOMIC_ACQUIRE, "agent");
      asm volatile("s_waitcnt vmcnt(0)" ::: "memory");
    }
  }
  __syncthreads();
}

DEVI float bf2f(u16 h) { return __uint_as_float(((unsigned)h) << 16); }
DEVI float bflo(unsigned w) { return __uint_as_float(w << 16); }
DEVI float bfhi(unsigned w) { return __uint_as_float(w & 0xffff0000u); }
DEVI unsigned pk_bf16(float lo, float hi) { unsigned r; asm("s_nop 1\n\tv_cvt_pk_bf16_f32 %0, %1, %2" : "=v"(r) : "v"(lo), "v"(hi)); return r; }
DEVI float sigmoidf_(float x) { return __builtin_amdgcn_rcpf(1.f + __expf(-x)); }
DEVI float gelu_tanh(float x) {
  const float y = 0.7978845608028654f * (x + 0.044715f * x * x * x);
  const float th = 1.f - 2.f * __builtin_amdgcn_rcpf(__expf(2.f * y) + 1.f);
  return 0.5f * x * (1.f + th);
}
DEVI float wave_sum(float v) {
#pragma unroll
  for (int o = 32; o > 0; o >>= 1) v += __shfl_xor(v, o);
  return v;
}
DEVI float wave_max(float v) {
#pragma unroll
  for (int o = 32; o > 0; o >>= 1) v = fmaxf(v, __shfl_xor(v, o));
  return v;
}

DEVI int swz(int row, int ch) { return row * 128 + ((ch ^ ((row >> 1) & 7)) << 4); }

DEVI void gemm_kloop(const u16* __restrict__ A, int lda, const u16* __restrict__ Bt, int ldb, int K, f32x4 (&acc)[4][4], unsigned char* smem) {
  const int tid = tid_(), lane = tid & 63, wid = tid >> 6, wr = wid >> 1, wc = wid & 1, fr = lane & 15, fq = lane >> 4;
  u32x4 r0a[4], r0b[4], r1a[4], r1b[4];
  const int nt = K >> 6;
  const int srow = tid >> 3, sch = tid & 7;
  const u16* ap = A + (size_t)srow * lda + sch * 8;
  const u16* bp = Bt + (size_t)srow * ldb + sch * 8;
#define G_LOAD(RA, RB, T) { const int ko_ = min((T), nt - 1) * 64; _Pragma("unroll") for (int i = 0; i < 4; ++i) { RA[i] = *(const u32x4*)(ap + (size_t)(32 * i) * lda + ko_); RB[i] = *(const u32x4*)(bp + (size_t)(32 * i) * ldb + ko_); } }
#define G_STORE(RA, RB, BUF) { _Pragma("unroll") for (int i = 0; i < 4; ++i) { *(u32x4*)((BUF) + swz(srow + 32 * i, sch)) = RA[i]; *(u32x4*)((BUF) + 16384 + swz(srow + 32 * i, sch)) = RB[i]; } }
#define G_COMPUTE(BUF) { _Pragma("unroll") for (int ks = 0; ks < 2; ++ks) { s16x8 af[4], bfr[4]; \
    _Pragma("unroll") for (int m = 0; m < 4; ++m) af[m] = *(const s16x8*)((BUF) + swz(wr * 64 + m * 16 + fr, ks * 4 + fq)); \
    _Pragma("unroll") for (int n = 0; n < 4; ++n) bfr[n] = *(const s16x8*)((BUF) + 16384 + swz(wc * 64 + n * 16 + fr, ks * 4 + fq)); \
    _Pragma("unroll") for (int m = 0; m < 4; ++m) _Pragma("unroll") for (int n = 0; n < 4; ++n) acc[m][n] = __builtin_amdgcn_mfma_f32_16x16x32_bf16(bfr[n], af[m], acc[m][n], 0, 0, 0); } }
  unsigned char* buf0 = smem; unsigned char* buf1 = smem + 32768;
  G_LOAD(r0a, r0b, 0);
  G_LOAD(r1a, r1b, 1);
  __syncthreads();
  G_STORE(r0a, r0b, buf0);
  G_LOAD(r0a, r0b, 2);
  __syncthreads();
#pragma unroll 1
  for (int t = 0; t < nt; t += 2) {
    G_COMPUTE(buf0);
    G_STORE(r1a, r1b, buf1);
    G_LOAD(r1a, r1b, t + 3);
    __syncthreads();
    G_COMPUTE(buf1);
    G_STORE(r0a, r0b, buf0);
    G_LOAD(r0a, r0b, t + 4);
    __syncthreads();
  }
#undef G_LOAD
#undef G_STORE
#undef G_COMPUTE
}

DEVI void zero_acc(f32x4 (&acc)[4][4]) {
#pragma unroll
  for (int m = 0; m < 4; ++m)
#pragma unroll
    for (int n = 0; n < 4; ++n) acc[m][n] = (f32x4){0.f, 0.f, 0.f, 0.f};
}


struct TileIter {
  int x, j, J, cm, nNt, u, total; bool xcd;
  DEVI void init(int nNt_) {
    const int G = gdim_(), b = bid_();
    nNt = nNt_; xcd = (G & 7) == 0;
    if (xcd) { x = b & 7; j = b >> 3; J = G >> 3; cm = (NMT - x + 7) >> 3; total = cm * nNt; }
    else { x = 0; j = b; J = G; cm = NMT; total = NMT * nNt; }
    u = j;
  }
  DEVI bool next(int& mt, int& nt) {
    if (u >= total) return false;
    if (xcd) {
      const int per_g = 8 * nNt, g = u / per_g, v = u - g * per_g;
      const int gm = min(8, cm - 8 * g);
      nt = v / gm; const int mi = v - nt * gm;
      mt = x + 8 * (8 * g + mi);
    } else { nt = u / NMT; mt = u - nt * NMT; }
    u += J;
    return true;
  }
};


template <class Epi>
DEVI void gemm_phase(const u16* A, int lda, const u16* Bt, int ldb, int K, int nNt, const Epi& epi, unsigned char* smem) {
  TileIter ti; ti.init(nNt);
  int mt, nt;
  const int wid = tid_() >> 6, wr = wid >> 1;
  while (ti.next(mt, nt)) {
    f32x4 acc[4][4];
    zero_acc(acc);
    gemm_kloop(A + (size_t)mt * 128 * lda, lda, Bt + (size_t)nt * 128 * ldb, ldb, K, acc, smem);
    epi(acc, mt * 128 + wr * 64, nt);
  }
}

constexpr int NMT2 = 65;
DEVI void gemm_kloop_big(const u16* __restrict__ A, int lda, const u16* __restrict__ Bt, int ldb, int K, f32x4 (&acc)[8][4], unsigned char* smem) {
  const int tid = tid_(), lane = tid & 63, wid = tid >> 6, wr = wid >> 1, wc = wid & 1, fr = lane & 15, fq = lane >> 4;
  u32x4 ra[8], rb[4];
  const int nt = K >> 6;
  const int srow = tid >> 3, sch = tid & 7;
  const u16* ap = A + (size_t)srow * lda + sch * 8;
  const u16* bp = Bt + (size_t)srow * ldb + sch * 8;
  unsigned char* sa = smem; unsigned char* sb = smem + 32768;
#pragma unroll
  for (int i = 0; i < 8; ++i) ra[i] = *(const u32x4*)(ap + (size_t)(32 * i) * lda);
#pragma unroll
  for (int i = 0; i < 4; ++i) rb[i] = *(const u32x4*)(bp + (size_t)(32 * i) * ldb);
  __syncthreads();
#pragma unroll 1
  for (int t = 0; t < nt; ++t) {
#pragma unroll
    for (int i = 0; i < 8; ++i) *(u32x4*)(sa + swz(srow + 32 * i, sch)) = ra[i];
#pragma unroll
    for (int i = 0; i < 4; ++i) *(u32x4*)(sb + swz(srow + 32 * i, sch)) = rb[i];
    __syncthreads();
    {
      const int ko = min(t + 1, nt - 1) * 64;
#pragma unroll
      for (int i = 0; i < 8; ++i) ra[i] = *(const u32x4*)(ap + (size_t)(32 * i) * lda + ko);
#pragma unroll
      for (int i = 0; i < 4; ++i) rb[i] = *(const u32x4*)(bp + (size_t)(32 * i) * ldb + ko);
    }
#pragma unroll
    for (int ks = 0; ks < 2; ++ks) {
      s16x8 bfr[4];
#pragma unroll
      for (int n = 0; n < 4; ++n) bfr[n] = *(const s16x8*)(sb + swz(wc * 64 + n * 16 + fr, ks * 4 + fq));
#pragma unroll
      for (int mh = 0; mh < 2; ++mh) {
        s16x8 af[4];
#pragma unroll
        for (int m = 0; m < 4; ++m) af[m] = *(const s16x8*)(sa + swz(wr * 128 + mh * 64 + m * 16 + fr, ks * 4 + fq));
#pragma unroll
        for (int m = 0; m < 4; ++m)
#pragma unroll
          for (int n = 0; n < 4; ++n) acc[mh * 4 + m][n] = __builtin_amdgcn_mfma_f32_16x16x32_bf16(bfr[n], af[m], acc[mh * 4 + m][n], 0, 0, 0);
      }
    }
    __syncthreads();
  }
}

template <class Epi>
DEVI void gemm_phase_big(const u16* A, int lda, const u16* Bt, int ldb, int K, int nNt, const Epi& epi, unsigned char* smem) {
  const int G = gdim_(), b = bid_();
  const bool xcd = (G & 7) == 0;
  const int x = xcd ? (b & 7) : 0, j = xcd ? (b >> 3) : b, J = xcd ? (G >> 3) : G;
  const int cm = xcd ? 8 : 64;
  const int total = cm * nNt;
  const int wid = tid_() >> 6, wr = wid >> 1;
#pragma unroll 1
  for (int u = j; u < total; u += J) {
    int mt, nt;
    if (xcd) { nt = u >> 3; mt = x + 8 * (u & 7); }
    else { nt = u >> 6; mt = u & 63; }
    f32x4 acc[8][4];
#pragma unroll
    for (int m = 0; m < 8; ++m)
#pragma unroll
      for (int n = 0; n < 4; ++n) acc[m][n] = (f32x4){0.f, 0.f, 0.f, 0.f};
    gemm_kloop_big(A + (size_t)mt * 256 * lda, lda, Bt + (size_t)nt * 128 * ldb, ldb, K, acc, smem);
    const int rb0 = mt * 256 + wr * 128;
    epi(*(const f32x4(*)[4][4])&acc[0], rb0, nt);
    epi(*(const f32x4(*)[4][4])&acc[4], rb0 + 64, nt);
  }
  const int step = xcd ? 8 : 1;
#pragma unroll 1
  for (int e = J - 1 - j, nt = x + step * e; nt < nNt; e += J, nt += step * J) {
    f32x4 acc[4][4];
    zero_acc(acc);
    gemm_kloop(A + (size_t)16384 * lda, lda, Bt + (size_t)nt * 128 * ldb, ldb, K, acc, smem);
    epi(acc, 16384 + wr * 64, nt);
  }
}

#define EPI_IDX const int tid = tid_(), lane = tid & 63, wid = tid >> 6, wr = wid >> 1, wc = wid & 1, fr = lane & 15, fq = lane >> 4; (void)wr; (void)wc; (void)fr; (void)fq;

DEVI void wave_tile_store_bf16(const u32x2 (&w)[4][4], u16* dst  , int ld, int lds_off = 0) {
  const int tid = tid_(), lane = tid & 63, wid = tid >> 6, fr = lane & 15, fq = lane >> 4;
  unsigned char* st = g_smem + lds_off + wid * 8192;
#pragma unroll
  for (int m = 0; m < 4; ++m)
#pragma unroll
    for (int n = 0; n < 4; ++n) *(u32x2*)(st + (m * 16 + fr) * 128 + (((n * 4 + fq) ^ fr) << 3)) = w[m][n];
  const int c = lane & 7;
#pragma unroll
  for (int i = 0; i < 8; ++i) {
    const int rl = (lane >> 3) + 8 * i, r15 = rl & 15;
    u32x4 q = *(const u32x4*)(st + rl * 128 + ((c ^ (r15 >> 1)) << 4));
    if (r15 & 1) q = (u32x4){q.z, q.w, q.x, q.y};
    *(u32x4*)(dst + (size_t)rl * ld + c * 8) = q;
  }
}

struct EpiA1 {
  u16* XL; u16* G;
  DEVI void operator()(const f32x4 (&acc)[4][4], int rowbase, int nt) const {
    EPI_IDX
    const bool isg = nt >= 10;
    u16* dst = isg ? G : XL;
    u32x2 w[4][4];
#pragma unroll
    for (int m = 0; m < 4; ++m)
#pragma unroll
      for (int n = 0; n < 4; ++n) {
        f32x4 v = acc[m][n];
        if (isg) { v[0] = gelu_tanh(v[0]); v[1] = gelu_tanh(v[1]); v[2] = gelu_tanh(v[2]); v[3] = gelu_tanh(v[3]); }
        w[m][n].x = pk_bf16(v[0], v[1]); w[m][n].y = pk_bf16(v[2], v[3]);
      }
    wave_tile_store_bf16(w, dst + (size_t)rowbase * 1280 + (isg ? nt - 10 : nt) * 128 + wc * 64, 1280);
  }
};

struct EpiB1 {
  u16* QA; float* CRAW; _Float16* QI; _Float16* KI; float* WI;
  DEVI void operator()(const f32x4 (&acc)[4][4], int rowbase, int nt) const {
    EPI_IDX
    if (nt == 16 || nt == 17) {
      unsigned char* st = g_smem + wid * 16384;
#pragma unroll
      for (int m = 0; m < 4; ++m)
#pragma unroll
        for (int n = 0; n < 4; ++n) *(f32x4*)(st + (m * 16 + fr) * 256 + (((n * 4 + fq) ^ fr) << 4)) = acc[m][n];
      const int un = lane & 15;
#pragma unroll
      for (int i = 0; i < 16; ++i) {
        const int rl = (lane >> 4) + 4 * i;
        const f32x4 a = *(const f32x4*)(st + rl * 256 + ((un ^ (rl & 15)) << 4));
        *(f32x4*)(CRAW + (size_t)(rowbase + rl) * 256 + (nt - 16) * 128 + wc * 64 + un * 4) = a;
      }
      return;
    }
    if (nt < 16 || (nt >= 18 && nt < 22)) {
      u32x2 w[4][4];
#pragma unroll
      for (int m = 0; m < 4; ++m)
#pragma unroll
        for (int n = 0; n < 4; ++n) {
          const f32x4 v = acc[m][n];
          if (nt < 16) { w[m][n].x = pk_bf16(v[0], v[1]); w[m][n].y = pk_bf16(v[2], v[3]); }
          else { union { h16x4 h; u32x2 u; } cv; cv.h[0] = (_Float16)v[0]; cv.h[1] = (_Float16)v[1]; cv.h[2] = (_Float16)v[2]; cv.h[3] = (_Float16)v[3]; w[m][n] = cv.u; }
        }
      if (nt < 16) wave_tile_store_bf16(w, QA + (size_t)rowbase * 2048 + nt * 128 + wc * 64, 2048);
      else wave_tile_store_bf16(w, (u16*)QI + (size_t)rowbase * 512 + (nt - 18) * 128 + wc * 64, 512);
      return;
    }
#pragma unroll
    for (int m = 0; m < 4; ++m) {
      const size_t row = (size_t)(rowbase + m * 16 + fr);
      if (nt < 16) {
      } else if (nt < 18) {
      } else if (nt < 22) {
      } else {
        if (wc == 0) {
          float s = 0.f;
#pragma unroll
          for (int n = 0; n < 4; ++n) s += (acc[m][n][0] + acc[m][n][1]) + (acc[m][n][2] + acc[m][n][3]);
          s += __shfl_xor(s, 16); s += __shfl_xor(s, 32);
          const float mu = s * (1.f / 64.f);
          float q = 0.f;
#pragma unroll
          for (int n = 0; n < 4; ++n)
#pragma unroll
            for (int j = 0; j < 4; ++j) { const float d = acc[m][n][j] - mu; q += d * d; }
          q += __shfl_xor(q, 16); q += __shfl_xor(q, 32);
          const float rs = rsqrtf(q * (1.f / 64.f) + LN_EPS);
#pragma unroll
          for (int n = 0; n < 4; ++n) {
            h16x4 h;
#pragma unroll
            for (int j = 0; j < 4; ++j) h[j] = (_Float16)((acc[m][n][j] - mu) * rs);
            *(h16x4*)(KI + row * 64 + n * 16 + fq * 4) = h;
          }
        } else if (fq < 2) {
          f32x4 v = acc[m][0] * 0.044194173824159216f;
          *(f32x4*)(WI + row * 8 + fq * 4) = v;
        }
      }
    }
  }
};

struct EpiRes {
  u16* R1; const float* bias;
  DEVI void operator()(const f32x4 (&acc)[4][4], int rowbase, int nt) const {
    EPI_IDX
    unsigned char* st = g_smem + wid * 16384;
#pragma unroll
    for (int m = 0; m < 4; ++m)
#pragma unroll
      for (int n = 0; n < 4; ++n) *(f32x4*)(st + (m * 16 + fr) * 256 + (((n * 4 + fq) ^ fr) << 4)) = acc[m][n];
    const int c = lane & 7;
    const int col0 = nt * 128 + wc * 64 + c * 8;
    f32x4 b0 = (f32x4){0.f, 0.f, 0.f, 0.f}, b1 = (f32x4){0.f, 0.f, 0.f, 0.f};
    if (bias) { b0 = *(const f32x4*)(bias + col0); b1 = *(const f32x4*)(bias + col0 + 4); }
#pragma unroll
    for (int i = 0; i < 8; ++i) {
      const int rl = (lane >> 3) + 8 * i, r15 = rl & 15;
      const f32x4 a0 = *(const f32x4*)(st + rl * 256 + (((2 * c) ^ r15) << 4));
      const f32x4 a1 = *(const f32x4*)(st + rl * 256 + (((2 * c + 1) ^ r15) << 4));
      u16* ptr = R1 + (size_t)(rowbase + rl) * 1024 + col0;
      const u32x4 x = *(const u32x4*)ptr;
      u32x4 w;
      w.x = pk_bf16(ALPHA * bflo(x.x) + a0[0] + b0[0], ALPHA * bfhi(x.x) + a0[1] + b0[1]);
      w.y = pk_bf16(ALPHA * bflo(x.y) + a0[2] + b0[2], ALPHA * bfhi(x.y) + a0[3] + b0[3]);
      w.z = pk_bf16(ALPHA * bflo(x.z) + a1[0] + b1[0], ALPHA * bfhi(x.z) + a1[1] + b1[1]);
      w.w = pk_bf16(ALPHA * bflo(x.w) + a1[2] + b1[2], ALPHA * bfhi(x.w) + a1[3] + b1[3]);
      *(u32x4*)ptr = w;
    }
  }
};

struct EpiUp {
  u16* H; const float* bias;
  DEVI void operator()(const f32x4 (&acc)[4][4], int rowbase, int nt) const {
    EPI_IDX
    u32x2 w[4][4];
#pragma unroll
    for (int n = 0; n < 4; ++n) {
      const int col = nt * 128 + wc * 64 + n * 16 + fq * 4;
      const f32x4 b = *(const f32x4*)(bias + col);
#pragma unroll
      for (int m = 0; m < 4; ++m) {
        f32x4 v = acc[m][n] + b;
#pragma unroll
        for (int j = 0; j < 4; ++j) { const float r = fmaxf(v[j], 0.f); v[j] = r * r; }
        w[m][n].x = pk_bf16(v[0], v[1]); w[m][n].y = pk_bf16(v[2], v[3]);
      }
    }
    wave_tile_store_bf16(w, H + (size_t)rowbase * 4096 + nt * 128 + wc * 64, 4096);
  }
};

DEVI void tr_job(const float* src, int lds_, int nvalid, u16* dst, int ldd, int K, int Npad, float* sm) {
  const int tid = tid_();
  const int nkt = K >> 6, nnt = Npad >> 6, ntl = nkt * nnt;
#pragma unroll 1
  for (int tile = bid_(); tile < ntl; tile += gdim_()) {
    const int ntile = tile / nkt, kt = tile - ntile * nkt;
    const int k0 = kt * 64, n0 = ntile * 64;
    __syncthreads();
#pragma unroll 16
    for (int it = 0; it < 16; ++it) {
      const int idx = tid + 256 * it, kk = idx >> 6, nn = idx & 63;
      float v = 0.f;
      if (n0 + nn < nvalid) v = src[(size_t)(k0 + kk) * lds_ + n0 + nn];
      sm[kk * 65 + nn] = v;
    }
    __syncthreads();
#pragma unroll 8
    for (int it = 0; it < 8; ++it) {
      const int idx = tid + 256 * it, nn = idx >> 5, kp = idx & 31;
      const unsigned w = pk_bf16(sm[(2 * kp) * 65 + nn], sm[(2 * kp + 1) * 65 + nn]);
      *(unsigned*)(dst + (size_t)(n0 + nn) * ldd + k0 + 2 * kp) = w;
    }
  }
}

DEVI void fold_tile(const float* L, int lsa, int lsd, const float* R, int rs, u16* dst, int ldd, float* sm) {
  const int tid = tid_();
  float* sL = sm; float* sR = sm + 64 * 129;
  __syncthreads();
  if (lsd == 1) {
#pragma unroll 16
    for (int it = 0; it < 32; ++it) { const int idx = tid + 256 * it, a = idx >> 7, d = idx & 127; sL[a * 129 + d] = L[(size_t)a * lsa + d]; }
  } else {
#pragma unroll 16
    for (int it = 0; it < 32; ++it) { const int idx = tid + 256 * it, a = idx & 63, d = idx >> 6; sL[a * 129 + d] = L[(size_t)a * lsa + (size_t)d * lsd]; }
  }
#pragma unroll 16
  for (int it = 0; it < 32; ++it) { const int idx = tid + 256 * it, b = idx >> 7, d = idx & 127; sR[b * 129 + d] = R[(size_t)b * rs + d]; }
  __syncthreads();
  const int ty = tid >> 4, tx = tid & 15;
  float o[4][4];
#pragma unroll
  for (int i = 0; i < 4; ++i)
#pragma unroll
    for (int j = 0; j < 4; ++j) o[i][j] = 0.f;
#pragma unroll 2
  for (int d = 0; d < 128; ++d) {
    float l[4], r[4];
#pragma unroll
    for (int i = 0; i < 4; ++i) l[i] = sL[(ty * 4 + i) * 129 + d];
#pragma unroll
    for (int j = 0; j < 4; ++j) r[j] = sR[(tx + 16 * j) * 129 + d];
#pragma unroll
    for (int i = 0; i < 4; ++i)
#pragma unroll
      for (int j = 0; j < 4; ++j) o[i][j] = fmaf(l[i], r[j], o[i][j]);
  }
#pragma unroll
  for (int i = 0; i < 4; ++i)
#pragma unroll
    for (int j = 0; j < 4; ++j) dst[(size_t)(ty * 4 + i) * ldd + tx + 16 * j] = (u16)(pk_bf16(o[i][j], 0.f) & 0xffff);
}

DEVI void convert_weights(PP p, int l, unsigned char* smem) {
  float* sm = (float*)smem;
  unsigned char* ws = p->ws;
  const float* w_in = p->in[4] + (size_t)l * 1024 * DIN;
  u16* W1 = (u16*)(ws + OFF_W1);
  tr_job(w_in, DIN, 2560, W1, 1024, 1024, 2560, sm);
  tr_job(w_in + 3584, DIN, 840, W1 + (size_t)4608 * 1024, 1024, 1024, 896, sm);
  tr_job(w_in + 4424, DIN, 2048, (u16*)(ws + OFF_WG), 1024, 1024, 2048, sm);
  tr_job(p->in[15] + (size_t)l * 1280 * 1024, 1024, 1024, (u16*)(ws + OFF_WBA), 1280, 1280, 1024, sm);
  tr_job(p->in[17] + (size_t)l * 1024 * 1024, 1024, 1024, (u16*)(ws + OFF_WO), 1024, 1024, 1024, sm);
  tr_job(p->in[20] + (size_t)l * 1024 * 4096, 4096, 4096, (u16*)(ws + OFF_WUP), 1024, 1024, 4096, sm);
  tr_job(p->in[22] + (size_t)l * 4096 * 1024, 1024, 1024, (u16*)(ws + OFF_WDN), 4096, 4096, 1024, sm);
#pragma unroll 1
  for (int nb = 0; nb < 10; ++nb) {
    tr_job(p->in[7] + (size_t)l * 163840 + nb * 16384, 128, 128, (u16*)(ws + OFF_WRA) + nb * 16384, 128, 128, 128, sm);
    tr_job(p->in[9] + (size_t)l * 163840 + nb * 16384, 128, 128, (u16*)(ws + OFF_WRX) + nb * 16384, 128, 128, 128, sm);
  }
  const float* w_uk = p->in[13] + (size_t)l * 8 * 256 * 128;
  const float* w_uv = p->in[14] + (size_t)l * 8 * 256 * 128;
  const float* w_bb = p->in[16] + (size_t)l * 1024 * 1024;
  u16* WOB = (u16*)(ws + OFF_WOB);
#pragma unroll 1
  for (int it = bid_(); it < 1024; it += gdim_()) {
    if (it < 512) {
      const int h = it >> 6, rt = (it >> 4) & 3, kt = it & 15;
      fold_tile(w_uk + ((size_t)h * 256 + rt * 64) * 128, 128, 1, w_in + (size_t)(kt * 64) * DIN + 2560 + h * 128, DIN,
                W1 + (size_t)(2560 + h * 256 + rt * 64) * 1024 + kt * 64, 1024, sm);
    } else {
      const int j = it - 512, h = j >> 6, ntile = (j >> 2) & 15, rt = j & 3;
      fold_tile(w_bb + (size_t)(128 * h) * 1024 + ntile * 64, 1, 1024, w_uv + ((size_t)h * 256 + rt * 64) * 128, 128,
                WOB + (size_t)(ntile * 64) * 2048 + h * 256 + rt * 64, 2048, sm);
    }
  }
}

DEVI void ln_rows_inplace(u16* R1, const float* g, const float* b, float* out  ) {
  const int lane = tid_() & 63, wid = tid_() >> 6;
  const int stride = gdim_() * 4;
  float gv[16], bv[16];
#pragma unroll
  for (int k = 0; k < 4; ++k) {
    const f32x4 g0 = *(const f32x4*)(g + 256 * k + lane * 4), b0 = *(const f32x4*)(b + 256 * k + lane * 4);
#pragma unroll
    for (int j = 0; j < 4; ++j) { gv[4 * k + j] = g0[j]; bv[4 * k + j] = b0[j]; }
  }
  int row = bid_() * 4 + wid;
  u32x2 x[4];
#pragma unroll
  for (int k = 0; k < 4; ++k) x[k] = (u32x2){0u, 0u};
  if (row < M_) {
    const u16* rp0 = R1 + (size_t)row * 1024 + lane * 4;
#pragma unroll
    for (int k = 0; k < 4; ++k) x[k] = *(const u32x2*)(rp0 + 256 * k);
  }
  for (; row < M_; row += stride) {
    u16* rp = R1 + (size_t)row * 1024 + lane * 4;
    const u16* np = R1 + (size_t)min(row + stride, M_ - 1) * 1024 + lane * 4;
    u32x2 nx[4];
#pragma unroll
    for (int k = 0; k < 4; ++k) nx[k] = *(const u32x2*)(np + 256 * k);
    float v[16];
#pragma unroll
    for (int k = 0; k < 4; ++k) { v[4 * k] = bflo(x[k].x); v[4 * k + 1] = bfhi(x[k].x); v[4 * k + 2] = bflo(x[k].y); v[4 * k + 3] = bfhi(x[k].y); }
    float s = 0.f;
#pragma unroll
    for (int j = 0; j < 16; ++j) s += v[j];
    const float mu = wave_sum(s) * (1.f / 1024.f);
    float q = 0.f;
#pragma unroll
    for (int j = 0; j < 16; ++j) { const float d = v[j] - mu; q += d * d; }
    const float rs = rsqrtf(wave_sum(q) * (1.f / 1024.f) + LN_EPS);
    float y[16];
#pragma unroll
    for (int j = 0; j < 16; ++j) y[j] = (v[j] - mu) * rs * gv[j] + bv[j];
    if (out) {
      const int bb = row >= T_ ? 1 : 0, t = row - bb * T_;
      if (t >= 16) {
        float* op = out + ((size_t)bb * 8192 + (t - 16)) * 1024 + lane * 4;
#pragma unroll
        for (int k = 0; k < 4; ++k) *(f32x4*)(op + 256 * k) = (f32x4){y[4 * k], y[4 * k + 1], y[4 * k + 2], y[4 * k + 3]};
      }
    } else {
#pragma unroll
      for (int k = 0; k < 4; ++k) { u32x2 w; w.x = pk_bf16(y[4 * k], y[4 * k + 1]); w.y = pk_bf16(y[4 * k + 2], y[4 * k + 3]); *(u32x2*)(rp + 256 * k) = w; }
    }
#pragma unroll
    for (int k = 0; k < 4; ++k) x[k] = nx[k];
  }
}

DEVI void ln_input(PP p) {
  const int lane = tid_() & 63, wid = tid_() >> 6;
  u16* R1 = (u16*)(p->ws + OFF_R1);
  const float* g = p->in[2]; const float* b = p->in[3];
  float gv[16], bv[16];
#pragma unroll
  for (int k = 0; k < 4; ++k) {
    const f32x4 g0 = *(const f32x4*)(g + 256 * k + lane * 4), b0 = *(const f32x4*)(b + 256 * k + lane * 4);
#pragma unroll
    for (int j = 0; j < 4; ++j) { gv[4 * k + j] = g0[j]; bv[4 * k + j] = b0[j]; }
  }
  for (int row = bid_() * 4 + wid; row < MP; row += gdim_() * 4) {
    u16* rp = R1 + (size_t)row * 1024 + lane * 4;
    if (row >= M_) {
      unsigned z = 0; asm volatile("" : "+v"(z));
#pragma unroll
      for (int k = 0; k < 4; ++k) *(u32x2*)(rp + 256 * k) = (u32x2){z, z};
      continue;
    }
    const int bb = row >= T_ ? 1 : 0, t = row - bb * T_;
    const float* src = (t < 16 ? p->in[1] + (size_t)t * 1024 : p->in[0] + ((size_t)bb * 8192 + (t - 16)) * 1024) + lane * 4;
    float v[16];
#pragma unroll
    for (int k = 0; k < 4; ++k) {
      const f32x4 a0 = *(const f32x4*)(src + 256 * k);
#pragma unroll
      for (int j = 0; j < 4; ++j) v[4 * k + j] = a0[j];
    }
    float s = 0.f;
#pragma unroll
    for (int j = 0; j < 16; ++j) s += v[j];
    const float mu = wave_sum(s) * (1.f / 1024.f);
    float q = 0.f;
#pragma unroll
    for (int j = 0; j < 16; ++j) { const float d = v[j] - mu; q += d * d; }
    const float rs = rsqrtf(wave_sum(q) * (1.f / 1024.f) + LN_EPS);
#pragma unroll
    for (int k = 0; k < 4; ++k) {
      float y[4];
#pragma unroll
      for (int j = 0; j < 4; ++j) y[j] = (v[4 * k + j] - mu) * rs * gv[4 * k + j] + bv[4 * k + j];
      u32x2 w; w.x = pk_bf16(y[0], y[1]); w.y = pk_bf16(y[2], y[3]);
      *(u32x2*)(rp + 256 * k) = w;
    }
  }
}

DEVI void gates_phase(PP p, int l, unsigned char* smem) {
  EPI_IDX
  unsigned char* ws = p->ws;
  const u16* XL = (const u16*)(ws + OFF_XL);
  u16* LA = (u16*)(ws + OFF_LA); u16* U = (u16*)(ws + OFF_U);
  const float* conv_w = p->in[5] + (size_t)l * 4 * 1280; const float* conv_b = p->in[6] + (size_t)l * 1280;
  const float* b_a = p->in[8] + (size_t)l * 1280; const float* b_x = p->in[10] + (size_t)l * 1280; const float* lam = p->in[11] + (size_t)l * 1280;
  unsigned char* sA = smem; unsigned char* sB = smem + 32768;
  TileIter ti; ti.init(10);
  int mt, nb;
  while (ti.next(mt, nb)) {
    const int r0 = mt * 128, ch0 = nb * 128;
    __syncthreads();
#pragma unroll 4
    for (int it = 0; it < 8; ++it) {
      const int idx = tid + 256 * it, row = idx >> 4, cc = idx & 15;
      const int R = r0 + row, ch = ch0 + cc * 8;
      float a[8];
      const f32x4 cb0 = *(const f32x4*)(conv_b + ch), cb1 = *(const f32x4*)(conv_b + ch + 4);
#pragma unroll
      for (int j = 0; j < 4; ++j) { a[j] = cb0[j]; a[4 + j] = cb1[j]; }
      if (R < M_) {
        const int t = R >= T_ ? R - T_ : R;
#pragma unroll
        for (int j = 0; j < 4; ++j) {
          if (t - 3 + j >= 0) {
            const u32x4 x = *(const u32x4*)(XL + (size_t)(R - 3 + j) * 1280 + ch);
            const f32x4 w0 = *(const f32x4*)(conv_w + j * 1280 + ch), w1 = *(const f32x4*)(conv_w + j * 1280 + ch + 4);
            a[0] = fmaf(w0[0], bflo(x[0]), a[0]); a[1] = fmaf(w0[1], bfhi(x[0]), a[1]);
            a[2] = fmaf(w0[2], bflo(x[1]), a[2]); a[3] = fmaf(w0[3], bfhi(x[1]), a[3]);
            a[4] = fmaf(w1[0], bflo(x[2]), a[4]); a[5] = fmaf(w1[1], bfhi(x[2]), a[5]);
            a[6] = fmaf(w1[2], bflo(x[3]), a[6]); a[7] = fmaf(w1[3], bfhi(x[3]), a[7]);
          }
        }
      } else {
#pragma unroll
        for (int j = 0; j < 8; ++j) a[j] = 0.f;
      }
      u32x4 w;
#pragma unroll
      for (int j = 0; j < 4; ++j) w[j] = pk_bf16(a[2 * j], a[2 * j + 1]);
      *(u32x4*)(sA + (cc >> 3) * 16384 + swz(row, cc & 7)) = w;
    }
    f32x4 acci[4][4];
    unsigned rpk[4][4][2];
#pragma unroll
    for (int pass = 0; pass < 2; ++pass) {
      const u16* Wt = (const u16*)(ws + (pass ? OFF_WRX : OFF_WRA)) + nb * 16384;
      if (pass) __syncthreads();
#pragma unroll 8
      for (int it = 0; it < 8; ++it) {
        const int idx = tid + 256 * it, row = idx >> 4, cc = idx & 15;
        *(u32x4*)(sB + (cc >> 3) * 16384 + swz(row, cc & 7)) = *(const u32x4*)(Wt + row * 128 + cc * 8);
      }
      __syncthreads();
      zero_acc(acci);
#pragma unroll
      for (int kt = 0; kt < 2; ++kt)
#pragma unroll
        for (int ks = 0; ks < 2; ++ks) {
          s16x8 af[4], bfr[4];
#pragma unroll
          for (int m = 0; m < 4; ++m) af[m] = *(const s16x8*)(sA + kt * 16384 + swz(wr * 64 + m * 16 + fr, ks * 4 + fq));
#pragma unroll
          for (int n = 0; n < 4; ++n) bfr[n] = *(const s16x8*)(sB + kt * 16384 + swz(wc * 64 + n * 16 + fr, ks * 4 + fq));
#pragma unroll
          for (int m = 0; m < 4; ++m)
#pragma unroll
            for (int n = 0; n < 4; ++n) acci[m][n] = __builtin_amdgcn_mfma_f32_16x16x32_bf16(bfr[n], af[m], acci[m][n], 0, 0, 0);
        }
      if (pass == 0) {
#pragma unroll
        for (int n = 0; n < 4; ++n) {
          const f32x4 ba = *(const f32x4*)(b_a + ch0 + wc * 64 + n * 16 + fq * 4);
#pragma unroll
          for (int m = 0; m < 4; ++m) {
            rpk[m][n][0] = pk_bf16(sigmoidf_(acci[m][n][0] + ba[0]), sigmoidf_(acci[m][n][1] + ba[1]));
            rpk[m][n][1] = pk_bf16(sigmoidf_(acci[m][n][2] + ba[2]), sigmoidf_(acci[m][n][3] + ba[3]));
          }
        }
      }
    }
    u32x2 wla[4][4], wu[4][4];
#pragma unroll
    for (int n = 0; n < 4; ++n) {
      const int cl = wc * 64 + n * 16 + fq * 4;
      const int ch = ch0 + cl;
      const f32x4 bx = *(const f32x4*)(b_x + ch), lm = *(const f32x4*)(lam + ch);
      float sp[4];
#pragma unroll
      for (int j = 0; j < 4; ++j) sp[j] = -8.f * __logf(1.f + __expf(-lm[j]));
#pragma unroll
      for (int m = 0; m < 4; ++m) {
        const int rl = wr * 64 + m * 16 + fr;
        const int R = r0 + rl;
        const u32x2 xw = *(const u32x2*)(sA + (cl >> 6) * 16384 + swz(rl, (cl & 63) >> 3) + (fq & 1) * 8);
        const float xc[4] = {bflo(xw.x), bfhi(xw.x), bflo(xw.y), bfhi(xw.y)};
        float la[4], u[4];
#pragma unroll
        for (int j = 0; j < 4; ++j) {
          const float r = (j & 1) ? bfhi(rpk[m][n][j >> 1]) : bflo(rpk[m][n][j >> 1]);
          const float ig = sigmoidf_(acci[m][n][j] + bx[j]);
          la[j] = sp[j] * r;
          { const float x2 = 2.f * la[j]; const float om = x2 > -0.02f ? -x2 * (1.f + x2 * (0.5f + x2 * (1.f / 6.f))) : 1.f - __expf(x2); u[j] = __builtin_amdgcn_sqrtf(fmaxf(om, 0.f)) * ig * xc[j]; }
          if (R == T_) la[j] = -1e30f;
        }
        wla[m][n].x = pk_bf16(la[0], la[1]); wla[m][n].y = pk_bf16(la[2], la[3]);
        wu[m][n].x = pk_bf16(u[0], u[1]); wu[m][n].y = pk_bf16(u[2], u[3]);
      }
    }
    __syncthreads();
    wave_tile_store_bf16(wla, LA + (size_t)(r0 + wr * 64) * 1280 + ch0 + wc * 64, 1280, 32768);
    wave_tile_store_bf16(wu, U + (size_t)(r0 + wr * 64) * 1280 + ch0 + wc * 64, 1280, 32768);
  }
}

constexpr int NCHUNK = 257;
DEVI void scan_summaries(PP p) {
  const u16* LA = (const u16*)(p->ws + OFF_LA); const u16* U = (const u16*)(p->ws + OFF_U);
  float* SL = (float*)(p->ws + OFF_SUML); float* SH = (float*)(p->ws + OFF_SUMH);
  for (int item = bid_(); item < NCHUNK * 3; item += gdim_()) {
    const int c = item / 3, cgp = item - c * 3;
    const int ch = cgp * 512 + tid_() * 2;
    if (ch >= 1280) continue;
    const int R0 = c * 64, nr = min(64, M_ - R0);
    float s0 = 0.f, s1 = 0.f, h0 = 0.f, h1 = 0.f;
#pragma unroll 32
    for (int r = 0; r < nr; ++r) {
      const unsigned lw = *(const unsigned*)(LA + (size_t)(R0 + r) * 1280 + ch);
      const unsigned uw = *(const unsigned*)(U + (size_t)(R0 + r) * 1280 + ch);
      const float l0 = bflo(lw), l1 = bfhi(lw);
      h0 = __expf(l0) * h0 + bflo(uw); h1 = __expf(l1) * h1 + bfhi(uw);
      s0 += l0; s1 += l1;
    }
    *(float2*)(SL + c * 1280 + ch) = make_float2(s0, s1);
    *(float2*)(SH + c * 1280 + ch) = make_float2(h0, h1);
  }
}
DEVI void scan_final(PP p) {
  const u16* LA = (const u16*)(p->ws + OFF_LA); const u16* U = (const u16*)(p->ws + OFF_U);
  u16* G = (u16*)(p->ws + OFF_G);
  const float* SL = (const float*)(p->ws + OFF_SUML); const float* SH = (const float*)(p->ws + OFF_SUMH);
  for (int item = bid_(); item < NCHUNK * 3; item += gdim_()) {
    const int c = item / 3, cgp = item - c * 3;
    const int ch = cgp * 512 + tid_() * 2;
    if (ch >= 1280) continue;
    float h0 = 0.f, h1 = 0.f;
#pragma unroll 32
    for (int cc = 0; cc < c; ++cc) {
      const float2 sl = *(const float2*)(SL + cc * 1280 + ch), sh = *(const float2*)(SH + cc * 1280 + ch);
      h0 = __expf(sl.x) * h0 + sh.x; h1 = __expf(sl.y) * h1 + sh.y;
    }
    const int R0 = c * 64, nr = min(64, M_ - R0);
#pragma unroll 32
    for (int r = 0; r < nr; ++r) {
      const size_t o = (size_t)(R0 + r) * 1280 + ch;
      const unsigned lw = *(const unsigned*)(LA + o), uw = *(const unsigned*)(U + o), gw = *(const unsigned*)(G + o);
      h0 = __expf(bflo(lw)) * h0 + bflo(uw); h1 = __expf(bfhi(lw)) * h1 + bfhi(uw);
      *(unsigned*)(G + o) = pk_bf16(h0 * bflo(gw), h1 * bfhi(gw));
    }
  }
}

DEVI void ckv_norm(PP p, int l) {
  const int lane = tid_() & 63, wid = tid_() >> 6;
  const float* CRAW = (const float*)(p->ws + OFF_CRAW); u16* CKV = (u16*)(p->ws + OFF_CKV);
  const f32x4 g = *(const f32x4*)(p->in[12] + (size_t)l * 256 + lane * 4);
  for (int row = bid_() * 4 + wid; row < MP; row += gdim_() * 4) {
    const f32x4 v = *(const f32x4*)(CRAW + (size_t)row * 256 + lane * 4);
    const float ss = wave_sum(v[0] * v[0] + v[1] * v[1] + v[2] * v[2] + v[3] * v[3]);
    const float rs = rsqrtf(ss * (1.f / 256.f) + LN_EPS);
    u32x2 w; w.x = pk_bf16(v[0] * rs * g[0], v[1] * rs * g[1]); w.y = pk_bf16(v[2] * rs * g[2], v[3] * rs * g[3]);
    *(u32x2*)(CKV + (size_t)row * 256 + lane * 4) = w;
  }
}

DEVI int score_bin(float s) {
  const unsigned u = __float_as_uint(s);
  int mg = (int)((u >> 19) & 0xFFF) - 1520;
  mg = min(max(mg, 0), 1023);
  return (u >> 31) ? 1023 - mg : 1024 + mg;
}

constexpr int TK_CAP = 1024;
DEVI void idx_scores(const f32x16& acc, const float (&wv)[2][8], float (&sc)[2]) {
#pragma unroll
  for (int s = 0; s < 2; ++s) {
    float v = 0.f;
#pragma unroll
    for (int i = 0; i < 4; ++i)
#pragma unroll
      for (int bb = 0; bb < 2; ++bb) v = fmaf(wv[s][2 * i + bb], __int_as_float(max(__float_as_int(acc[4 * i + 2 * s + bb]), 0)), v);
    sc[s] = v;
  }
}

DEVI unsigned f2ord(float s) { const unsigned u = __float_as_uint(s); return u ^ ((unsigned)((int)u >> 31) | 0x80000000u); }
DEVI unsigned bin_lower_ord(int b) {
  if (b >= 1024) { const int mg = b - 1024; return mg == 0 ? 0x80000000u : (((unsigned)(mg + 1520) << 19) | 0x80000000u); }
  const int mg = 1023 - b;
  const unsigned bmax = mg == 1023 ? 0x7FFFFFFFu : (((unsigned)(mg + 1 + 1520) << 19) - 1u);
  return ~(0x80000000u | bmax);
}
DEVI void hist_search(const unsigned* hq, int lane, int Kt, int& bstar, int& nabove, int& total) {
  int sL = 0;
#pragma unroll
  for (int w = 0; w < 16; ++w) { const unsigned x = hq[1008 - 16 * lane + w]; sL += (int)(x & 0xffff) + (int)(x >> 16); }
  int P = sL;
#pragma unroll
  for (int o = 1; o < 64; o <<= 1) { const int y = __shfl_up(P, o); if (lane >= o) P += y; }
  total = __shfl(P, 63);
  const unsigned long long mk = __ballot(P >= Kt);
  if (mk == 0ull) { bstar = -1; nabove = total; return; }
  const int Ls = __ffsll((long long)mk) - 1;
  const int above0 = __shfl(P - sL, Ls);
  const int base_bin = 2047 - 32 * Ls;
  const int mybin = base_bin - (lane & 31);
  const int cntk = (int)((hq[mybin >> 1] >> ((mybin & 1) * 16)) & 0xffff);
  int Ck = cntk;
#pragma unroll
  for (int o = 1; o < 32; o <<= 1) { const int y = __shfl_up(Ck, o); if ((lane & 31) >= o) Ck += y; }
  const unsigned long long m2 = __ballot(lane < 32 && above0 + Ck >= Kt);
  const int ks = m2 ? (__ffsll((long long)m2) - 1) : 31;
  bstar = base_bin - ks;
  nabove = above0 + __shfl(Ck - cntk, ks);
}
DEVI void score4(const h16x8 (&qf)[2][4], const h16x8 (&kf)[4], const float (&wv)[2][2][8], float (&sc)[2][2]) {
#pragma unroll
  for (int rb = 0; rb < 2; ++rb) {
    f32x16 acc;
#pragma unroll
    for (int i = 0; i < 16; ++i) acc[i] = 0.f;
#pragma unroll
    for (int ks = 0; ks < 4; ++ks) acc = __builtin_amdgcn_mfma_f32_32x32x16_f16(qf[rb][ks], kf[ks], acc, 0, 0, 0);
    idx_scores(acc, wv[rb], sc[rb]);
  }
}

DEVI void topk_phase(PP p, unsigned char* smem) {
  const int tid = tid_(), lane = tid & 63, wid = tid >> 6;
  const _Float16* QI = (const _Float16*)(p->ws + OFF_QI); const _Float16* KI = (const _Float16*)(p->ws + OFF_KI);
  const float* WI = (const float*)(p->ws + OFF_WI); u16* SEL = (u16*)(p->ws + OFF_SEL);
  unsigned* hist = (unsigned*)smem;
  unsigned* cand_o = (unsigned*)smem;
  u16* cand_i = (u16*)(smem + 32768);
  unsigned* bm = (unsigned*)(smem + 49152);
  int* meta = (int*)(smem + 49152 + 8448);
  const int r = lane & 31, hi = lane >> 5;
  const int a_head = 2 * (r >> 3) + (r & 1), a_ql = 2 * ((r >> 2) & 1) + ((r >> 1) & 1);
  const int G = gdim_();
  for (int rnd = 0;; ++rnd) {
    const int j = rnd * G + ((rnd & 1) ? (G - 1 - bid_()) : bid_());
    if (j >= 2052) break;
    const int bb = j & 1, qt = 1025 - (j >> 1);
    const int t0 = qt * 8, Rb = bb * T_ + t0;
    const int nchunks = (t0 + 7) / 32 + 1;
    const bool small = (t0 + 8) <= TK_CAP;
    __syncthreads();
    for (int i = tid; i < 8192; i += 256) hist[i] = 0;
    for (int i = tid; i < 8 * 264; i += 256) bm[i] = 0;
    if (tid < 32) meta[tid] = 0;
    h16x8 qf[2][4]; float wv[2][2][8]; int tq[2][2];
#pragma unroll
    for (int rb = 0; rb < 2; ++rb) {
#pragma unroll
      for (int ks = 0; ks < 4; ++ks) qf[rb][ks] = *(const h16x8*)(QI + (size_t)(Rb + rb * 4 + a_ql) * 512 + a_head * 64 + ks * 16 + hi * 8);
#pragma unroll
      for (int s = 0; s < 2; ++s) {
        const int ql = rb * 4 + 2 * hi + s;
        tq[rb][s] = t0 + ql;
        const f32x4 w0 = *(const f32x4*)(WI + (size_t)(Rb + ql) * 8), w1 = *(const f32x4*)(WI + (size_t)(Rb + ql) * 8 + 4);
#pragma unroll
        for (int h = 0; h < 4; ++h) { wv[rb][s][h] = w0[h]; wv[rb][s][4 + h] = w1[h]; }
      }
    }
    const _Float16* kbase = KI + (size_t)(bb * T_ + r) * 64 + hi * 8;
    __syncthreads();
    if (!small) {
      h16x8 ks2[2][4];
      {
        const int c = min(16 * wid, nchunks - 1);
#pragma unroll
        for (int ks = 0; ks < 4; ++ks) ks2[0][ks] = *(const h16x8*)(kbase + (size_t)c * 2048 + ks * 16);
      }
#pragma unroll 1
      for (int cb = 16 * wid; cb < nchunks; cb += 128) {
#pragma unroll
        for (int u = 0; u < 2; ++u) {
          const int c = cb + 64 * u;
          const int cn = min(c + 64, nchunks - 1);
#pragma unroll
          for (int ks = 0; ks < 4; ++ks) ks2[u ^ 1][ks] = *(const h16x8*)(kbase + (size_t)cn * 2048 + ks * 16);
          float sc[2][2];
          score4(qf, ks2[u], wv, sc);
          const int key = c * 32 + r;
#pragma unroll
          for (int rb = 0; rb < 2; ++rb)
#pragma unroll
            for (int s = 0; s < 2; ++s)
              if (key <= tq[rb][s] && c < nchunks) { const int bin = score_bin(sc[rb][s]); atomicAdd(&hist[(rb * 4 + 2 * hi + s) * 1024 + (bin >> 1)], 1u << ((bin & 1) * 16)); }
        }
      }
      __syncthreads();
#pragma unroll 1
      for (int qq = 0; qq < 2; ++qq) {
        const int q8 = wid * 2 + qq, n = t0 + q8 + 1;
        int bstar, nabove, total;
        int ns = 0;
#pragma unroll
        for (int w = 0; w < 16; ++w) { const unsigned xw = hist[q8 * 1024 + 16 * lane + w]; ns += (int)(xw & 0xffff) + (int)(xw >> 16); }
#pragma unroll
        for (int o = 32; o > 0; o >>= 1) ns += __shfl_xor(ns, o);
        const float r0 = 256.f * (float)ns / (float)n;
        const int rs = (int)(r0 + 3.f * sqrtf(r0) + 9.f);
        hist_search(hist + q8 * 1024, lane, rs, bstar, nabove, total);
        if (lane == 0) meta[q8] = (int)(bstar < 0 ? 0u : bin_lower_ord(bstar));
      }
      __syncthreads();
    }
    {
      unsigned cutv[2][2];
#pragma unroll
      for (int rb = 0; rb < 2; ++rb)
#pragma unroll
        for (int s = 0; s < 2; ++s) cutv[rb][s] = (unsigned)meta[rb * 4 + 2 * hi + s];
      h16x8 kr[2][4];
      {
        const int c = min(wid, nchunks - 1);
#pragma unroll
        for (int ks = 0; ks < 4; ++ks) kr[0][ks] = *(const h16x8*)(kbase + (size_t)c * 2048 + ks * 16);
      }
#pragma unroll 1
      for (int cb = wid; cb < nchunks; cb += 8) {
#pragma unroll
        for (int u = 0; u < 2; ++u) {
          const int c = cb + 4 * u;
          const int cn = min(c + 4, nchunks - 1);
#pragma unroll
          for (int ks = 0; ks < 4; ++ks) kr[u ^ 1][ks] = *(const h16x8*)(kbase + (size_t)cn * 2048 + ks * 16);
          float sc[2][2];
          score4(qf, kr[u], wv, sc);
          const int key = c * 32 + r;
#pragma unroll
          for (int rb = 0; rb < 2; ++rb)
#pragma unroll
            for (int s = 0; s < 2; ++s) {
              const unsigned od = f2ord(sc[rb][s]);
              if (key <= tq[rb][s] && c < nchunks && od >= cutv[rb][s]) {
                const int q8 = rb * 4 + 2 * hi + s;
                const int pos = atomicAdd(&meta[24 + q8], 1);
                if (pos < TK_CAP) { cand_o[q8 * TK_CAP + pos] = od; cand_i[q8 * TK_CAP + pos] = (u16)key; }
              }
            }
        }
      }
    }
    __syncthreads();
    if (tid < 8) { const int C = meta[24 + tid], keff = min(256, t0 + tid + 1); if (C < keff || C > TK_CAP) atomicOr(&meta[16], 1); }
    __syncthreads();
    const int fb = meta[16];
    if (!fb) {
#pragma unroll 1
      for (int qq = 0; qq < 2; ++qq) {
        const int q8 = wid * 2 + qq, C = meta[24 + q8], keff = min(256, t0 + q8 + 1);
        const unsigned* co = cand_o + q8 * TK_CAP; const u16* ci = cand_i + q8 * TK_CAP;
        if (C <= keff) {
          for (int i = lane; i < C; i += 64) { const int ii = ci[i]; atomicOr(&bm[q8 * 264 + (ii >> 5)], 1u << (ii & 31)); }
        } else {
          unsigned ov[16];
#pragma unroll
          for (int u = 0; u < 16; ++u) { const int i = u * 64 + lane; ov[u] = i < C ? co[i] : 0u; }
          unsigned T = 0u;
#pragma unroll 1
          for (int bit = 31; bit >= 0; --bit) {
            const unsigned trial = T | (1u << bit);
            int cnt = 0;
#pragma unroll
            for (int u = 0; u < 16; ++u) cnt += __popcll(__ballot(ov[u] >= trial));
            if (cnt >= keff) T = trial;
          }
          int ngt = 0;
#pragma unroll
          for (int u = 0; u < 16; ++u) ngt += __popcll(__ballot(ov[u] > T));
          const int need = keff - ngt;
#pragma unroll
          for (int u = 0; u < 16; ++u) {
            const int i = u * 64 + lane;
            if (i < C && ov[u] > T) { const int ii = ci[i]; atomicOr(&bm[q8 * 264 + (ii >> 5)], 1u << (ii & 31)); }
          }
          int lastkey = -1;
#pragma unroll 1
          for (int ts = 0; ts < need; ++ts) {
            int best = 0x7fffffff;
#pragma unroll
            for (int u = 0; u < 16; ++u) {
              const int i = u * 64 + lane;
              if (i < C && ov[u] == T) { const int k = ci[i]; if (k > lastkey && k < best) best = k; }
            }
#pragma unroll
            for (int o = 32; o > 0; o >>= 1) best = min(best, __shfl_xor(best, o));
            if (best == 0x7fffffff) break;
            if (lane == 0) atomicOr(&bm[q8 * 264 + (best >> 5)], 1u << (best & 31));
            lastkey = best;
          }
        }
      }
    } else {
      __syncthreads();
      for (int i = tid; i < 8192; i += 256) hist[i] = 0;
      if (tid < 32) meta[tid] = 0;
      __syncthreads();
#pragma unroll 1
      for (int pass = 0; pass < 2; ++pass) {
        int bst[2][2];
        if (pass) {
#pragma unroll
          for (int rb = 0; rb < 2; ++rb)
#pragma unroll
            for (int s = 0; s < 2; ++s) bst[rb][s] = meta[rb * 4 + 2 * hi + s];
        }
#pragma unroll 1
        for (int c = wid; c < nchunks; c += 4) {
          h16x8 kf[4];
#pragma unroll
          for (int ks = 0; ks < 4; ++ks) kf[ks] = *(const h16x8*)(kbase + (size_t)c * 2048 + ks * 16);
          float sc[2][2];
          score4(qf, kf, wv, sc);
          const int key = c * 32 + r;
#pragma unroll
          for (int rb = 0; rb < 2; ++rb)
#pragma unroll
            for (int s = 0; s < 2; ++s) {
              if (key <= tq[rb][s]) {
                const int q8 = rb * 4 + 2 * hi + s;
                const int bin = score_bin(sc[rb][s]);
                if (!pass) {
                  atomicAdd(&hist[q8 * 1024 + (bin >> 1)], 1u << ((bin & 1) * 16));
                } else {
                  if (bin > bst[rb][s]) atomicOr(&bm[q8 * 264 + (key >> 5)], 1u << (key & 31));
                  else if (bin == bst[rb][s]) { const int pos = atomicAdd(&meta[24 + q8], 1); if (pos < TK_CAP) { cand_o[q8 * TK_CAP + pos] = f2ord(sc[rb][s]); cand_i[q8 * TK_CAP + pos] = (u16)key; } }
                }
              }
            }
        }
        __syncthreads();
        if (!pass) {
          int bres[2], ares[2];
#pragma unroll
          for (int qq = 0; qq < 2; ++qq) {
            const int q8 = wid * 2 + qq, nvalid = t0 + q8 + 1;
            int bstar = -1, nabove = nvalid, total;
            if (nvalid > 256) hist_search(hist + q8 * 1024, lane, 256, bstar, nabove, total);
            bres[qq] = bstar; ares[qq] = nabove;
          }
          __syncthreads();
          if (lane == 0) { meta[wid * 2] = bres[0]; meta[wid * 2 + 1] = bres[1]; meta[8 + wid * 2] = ares[0]; meta[8 + wid * 2 + 1] = ares[1]; }
          __syncthreads();
        }
      }
#pragma unroll 1
      for (int qq = 0; qq < 2; ++qq) {
        const int q8 = wid * 2 + qq, nvalid = t0 + q8 + 1;
        if (nvalid > 256) {
          const int need = 256 - meta[8 + q8];
          const int cn = min(meta[24 + q8], TK_CAP);
          const unsigned* co = cand_o + q8 * TK_CAP; const u16* ci = cand_i + q8 * TK_CAP;
          for (int i = lane; i < cn; i += 64) {
            const unsigned oi = co[i]; const int ii = ci[i];
            int rank = 0;
            for (int k = 0; k < cn; ++k) { const unsigned ok = co[k]; const int ik = ci[k]; rank += (ok > oi || (ok == oi && ik < ii)) ? 1 : 0; }
            if (rank < need) atomicOr(&bm[q8 * 264 + (ii >> 5)], 1u << (ii & 31));
          }
        }
      }
    }
    __syncthreads();
#pragma unroll 1
    for (int qq = 0; qq < 2; ++qq) {
      const int q8 = wid * 2 + qq;
      u16* srow = SEL + (size_t)(Rb + q8) * 256;
      unsigned wds[5]; int cnt = 0;
#pragma unroll
      for (int i = 0; i < 5; ++i) { const int idx = 5 * lane + i; wds[i] = idx < 257 ? bm[q8 * 264 + idx] : 0u; cnt += __popc(wds[i]); }
      int P = cnt;
#pragma unroll
      for (int o = 1; o < 64; o <<= 1) { const int y = __shfl_up(P, o); if (lane >= o) P += y; }
      const int total = __shfl(P, 63);
      int pos = P - cnt;
#pragma unroll
      for (int i = 0; i < 5; ++i) {
        unsigned w = wds[i];
        while (w) { const int b = __ffs((int)w) - 1; if (pos < 256) srow[pos] = (u16)((5 * lane + i) * 32 + b); ++pos; w &= w - 1; }
      }
      for (int pp = total + lane; pp < 256; pp += 64) srow[pp] = (u16)0xFFFF;
    }
  }
}

#define TR8(d0, d1, d2, d3, d4, d5, d6, d7, a0, a1)                                                                   \
  asm volatile("ds_read_b64_tr_b16 %0, %8\n\tds_read_b64_tr_b16 %1, %9\n\t"                                         \
               "ds_read_b64_tr_b16 %2, %8 offset:32\n\tds_read_b64_tr_b16 %3, %9 offset:32\n\t"                     \
               "ds_read_b64_tr_b16 %4, %8 offset:64\n\tds_read_b64_tr_b16 %5, %9 offset:64\n\t"                     \
               "ds_read_b64_tr_b16 %6, %8 offset:96\n\tds_read_b64_tr_b16 %7, %9 offset:96\n\ts_waitcnt lgkmcnt(0)" \
               : "=&v"(d0), "=&v"(d1), "=&v"(d2), "=&v"(d3), "=&v"(d4), "=&v"(d5), "=&v"(d6), "=&v"(d7)              \
               : "v"(a0), "v"(a1)                                                                                     \
               : "memory")

DEVI void attn_phase(PP p, int l, unsigned char* smem, bool dummy = false) {
  const int tid = tid_(), lane = tid & 63, wid = tid >> 6, fr = lane & 15, fq = lane >> 4;
  u16* QA = (u16*)(p->ws + OFF_QA); const u16* CKV = (const u16*)(p->ws + OFF_CKV); const u16* SEL = (const u16*)(p->ws + OFF_SEL);
  unsigned char* buf = smem + wid * 17408;
  float gm;
  { const f32x4 g = *(const f32x4*)(p->in[12] + (size_t)l * 256 + lane * 4);
    gm = wave_max(fmaxf(fmaxf(fabsf(g[0]), fabsf(g[1])), fmaxf(fabsf(g[2]), fabsf(g[3])))); }
  const float cmax = 16.f * gm * 1.01f;
  const unsigned lbase = (unsigned)(uintptr_t)buf;
  const unsigned tr_a0 = lbase + (4 * fq + (fr >> 2)) * 544 + (fr & 3) * 8;
  const unsigned tr_a1 = tr_a0 + 16 * 544;
  const int Gd = gdim_(), bidx = bid_();
  const bool part_ok = (Gd & 7) == 0;
  const int part = bidx & 7, g0 = part_ok ? (bidx >> 3) : bidx, gstep = part_ok ? (Gd >> 3) : Gd, gend = part_ok ? 513 : M_ / 4;
  const int gslot = lane >> 3, gch = lane & 7;
  for (int grp = g0; grp < gend; grp += gstep) {
    const int R = part_ok ? ((part & 1) * T_ + (part >> 1) * 2052 + grp * 4 + wid) : grp * 4 + wid;
    const int bb = R >= T_ ? 1 : 0, t = R - bb * T_;
    const int keff = min(256, t + 1);
    const u16* cbase = CKV + (size_t)bb * T_ * 256 + gch * 8;
    const u16* selr = SEL + (size_t)R * 256 + gslot;
    s16x8 qf[8];
    {
#pragma unroll
      for (int i = 0; i < 4; ++i) {
        const int pp = lane + 64 * i, hd = pp >> 5, chn = pp & 31;
        *(u32x4*)(buf + hd * 528 + chn * 16) = *(const u32x4*)(QA + (size_t)R * 2048 + hd * 256 + chn * 8);
      }
#pragma unroll
      for (int ks = 0; ks < 8; ++ks) {
        qf[ks] = (s16x8){0, 0, 0, 0, 0, 0, 0, 0};
        if (fr < 8) qf[ks] = *(const s16x8*)(buf + fr * 528 + (ks * 4 + fq) * 16);
      }
    }
    unsigned ix[4];
#pragma unroll
    for (int i = 0; i < 4; ++i) ix[i] = selr[8 * i];
    s16x8 g[16];
#pragma unroll
    for (int i = 0; i < 4; ++i) {
      const u16* pr = cbase + (size_t)(ix[i] == 0xFFFFu ? 0u : ix[i]) * 256;
#pragma unroll
      for (int j = 0; j < 4; ++j) g[4 * i + j] = *(const s16x8*)(pr + j * 64);
    }
#pragma unroll
    for (int i = 0; i < 4; ++i) ix[i] = selr[32 + 8 * i];
    float nq = 0.f;
#pragma unroll
    for (int ks = 0; ks < 8; ++ks)
#pragma unroll
      for (int e = 0; e < 8; ++e) { const float x = bf2f((u16)qf[ks][e]); nq = fmaf(x, x, nq); }
    nq += __shfl_xor(nq, 16); nq += __shfl_xor(nq, 32);
    const float mb = ATT_SCALE * sqrtf(nq) * cmax;
    f32x4 o[16];
#pragma unroll
    for (int d = 0; d < 16; ++d) o[d] = (f32x4){0.f, 0.f, 0.f, 0.f};
    float lsum = 0.f;
#pragma unroll 1
    for (int c = 0; c < 8; ++c) {
#pragma unroll
      for (int i = 0; i < 4; ++i)
#pragma unroll
        for (int j = 0; j < 4; ++j) *(s16x8*)(buf + (gslot + 8 * i) * 544 + (gch + 8 * j) * 16) = g[4 * i + j];
      {
#pragma unroll
        for (int i = 0; i < 4; ++i) {
          const u16* pr = cbase + (size_t)(ix[i] == 0xFFFFu ? 0u : ix[i]) * 256;
#pragma unroll
          for (int j = 0; j < 4; ++j) g[4 * i + j] = *(const s16x8*)(pr + j * 64);
        }
        const int c2 = min(c + 2, 7);
#pragma unroll
        for (int i = 0; i < 4; ++i) ix[i] = selr[c2 * 32 + 8 * i];
      }
      f32x4 sa = {0.f, 0.f, 0.f, 0.f}, sb = {0.f, 0.f, 0.f, 0.f};
#pragma unroll
      for (int ks = 0; ks < 8; ++ks) {
        const s16x8 fa = *(const s16x8*)(buf + fr * 544 + (ks * 4 + fq) * 16);
        const s16x8 fb = *(const s16x8*)(buf + (16 + fr) * 544 + (ks * 4 + fq) * 16);
        sa = __builtin_amdgcn_mfma_f32_16x16x32_bf16(fa, qf[ks], sa, 0, 0, 0);
        sb = __builtin_amdgcn_mfma_f32_16x16x32_bf16(fb, qf[ks], sb, 0, 0, 0);
      }
      float pa_[4], pb_[4];
#pragma unroll
      for (int jj = 0; jj < 4; ++jj) {
        const int posa = c * 32 + 4 * fq + jj;
        pa_[jj] = posa < keff ? __expf(sa[jj] * ATT_SCALE - mb) : 0.f;
        pb_[jj] = posa + 16 < keff ? __expf(sb[jj] * ATT_SCALE - mb) : 0.f;
        lsum += pa_[jj] + pb_[jj];
      }
      union { u32x4 u; s16x8 s; } pf;
      pf.u[0] = pk_bf16(pa_[0], pa_[1]); pf.u[1] = pk_bf16(pa_[2], pa_[3]); pf.u[2] = pk_bf16(pb_[0], pb_[1]); pf.u[3] = pk_bf16(pb_[2], pb_[3]);
      asm volatile("s_waitcnt lgkmcnt(0)" ::: "memory");
      {
        u32x2 e[1][8];
#define TRI(g_, E) asm volatile("ds_read_b64_tr_b16 %0, %8\n\tds_read_b64_tr_b16 %1, %9\n\t" \
               "ds_read_b64_tr_b16 %2, %8 offset:32\n\tds_read_b64_tr_b16 %3, %9 offset:32\n\t" \
               "ds_read_b64_tr_b16 %4, %8 offset:64\n\tds_read_b64_tr_b16 %5, %9 offset:64\n\t" \
               "ds_read_b64_tr_b16 %6, %8 offset:96\n\tds_read_b64_tr_b16 %7, %9 offset:96" \
               : "=&v"(E[0]), "=&v"(E[1]), "=&v"(E[2]), "=&v"(E[3]), "=&v"(E[4]), "=&v"(E[5]), "=&v"(E[6]), "=&v"(E[7]) \
               : "v"(tr_a0 + (g_) * 128), "v"(tr_a1 + (g_) * 128) : "memory")
#define TRW(N, E) asm volatile("s_waitcnt lgkmcnt(" #N ")" : "+v"(E[0]), "+v"(E[1]), "+v"(E[2]), "+v"(E[3]), "+v"(E[4]), "+v"(E[5]), "+v"(E[6]), "+v"(E[7]) :: "memory")
#define PVM(g_, E) { union { u32x4 u; s16x8 s; } c0, c1, c2, c3; \
          c0.u = (u32x4){E[0].x, E[0].y, E[1].x, E[1].y}; c1.u = (u32x4){E[2].x, E[2].y, E[3].x, E[3].y}; \
          c2.u = (u32x4){E[4].x, E[4].y, E[5].x, E[5].y}; c3.u = (u32x4){E[6].x, E[6].y, E[7].x, E[7].y}; \
          o[(g_) * 4 + 0] = __builtin_amdgcn_mfma_f32_16x16x32_bf16(c0.s, pf.s, o[(g_) * 4 + 0], 0, 0, 0); \
          o[(g_) * 4 + 1] = __builtin_amdgcn_mfma_f32_16x16x32_bf16(c1.s, pf.s, o[(g_) * 4 + 1], 0, 0, 0); \
          o[(g_) * 4 + 2] = __builtin_amdgcn_mfma_f32_16x16x32_bf16(c2.s, pf.s, o[(g_) * 4 + 2], 0, 0, 0); \
          o[(g_) * 4 + 3] = __builtin_amdgcn_mfma_f32_16x16x32_bf16(c3.s, pf.s, o[(g_) * 4 + 3], 0, 0, 0); }
        TRI(0, e[0]); TRW(0, e[0]); PVM(0, e[0]);
        TRI(1, e[0]); TRW(0, e[0]); PVM(1, e[0]);
        TRI(2, e[0]); TRW(0, e[0]); PVM(2, e[0]);
        TRI(3, e[0]); TRW(0, e[0]); PVM(3, e[0]);
#undef TRI
#undef TRW
#undef PVM
      }
    }
    lsum += __shfl_xor(lsum, 16); lsum += __shfl_xor(lsum, 32);
    const float inv = 1.f / lsum;
    if (fr < 8) {
#pragma unroll
      for (int d = 0; d < 16; ++d) {
        u32x2 w; w.x = pk_bf16(o[d][0] * inv, o[d][1] * inv); w.y = pk_bf16(o[d][2] * inv, o[d][3] * inv);
        *(u32x2*)(buf + fr * 528 + d * 32 + fq * 8) = w;
      }
    }
    {
      u16* orow = dummy ? (u16*)p->out + (size_t)(R < 16384 ? R : 0) * 2048 : QA + (size_t)R * 2048;
#pragma unroll
      for (int i = 0; i < 4; ++i) {
        const int pp = lane + 64 * i, hd = pp >> 5, chn = pp & 31;
        const u32x4 q = *(const u32x4*)(buf + hd * 528 + chn * 16);
        *(u32x4*)(orow + hd * 256 + chn * 8) = q;
      }
    }
  }
}

DEVI void merge_phase(PP p, unsigned char* smem) {
  EPI_IDX
  unsigned char* ws = p->ws;
  const u16* XB = (const u16*)(ws + OFF_R1); const u16* HG = (const u16*)(ws + OFF_G); const u16* OL = (const u16*)(ws + OFF_QA);
  const u16* WG = (const u16*)(ws + OFF_WG); const u16* WBA = (const u16*)(ws + OFF_WBA); const u16* WOB = (const u16*)(ws + OFF_WOB);
  u16* MIX = (u16*)(ws + OFF_MIX);
  TileIter ti; ti.init(8);
  int mt, nt;
  while (ti.next(mt, nt)) {
    f32x4 acc[4][4];
    unsigned sg[4][4][2];
#pragma unroll 1
    for (int br = 0; br < 2; ++br) {
      zero_acc(acc);
      gemm_kloop(XB + (size_t)mt * 128 * 1024, 1024, WG + (size_t)(br * 1024 + nt * 128) * 1024, 1024, 1024, acc, smem);
#pragma unroll
      for (int m = 0; m < 4; ++m)
#pragma unroll
        for (int n = 0; n < 4; ++n) { sg[m][n][0] = pk_bf16(sigmoidf_(acc[m][n][0]), sigmoidf_(acc[m][n][1])); sg[m][n][1] = pk_bf16(sigmoidf_(acc[m][n][2]), sigmoidf_(acc[m][n][3])); }
      zero_acc(acc);
      if (br == 0) gemm_kloop(HG + (size_t)mt * 128 * 1280, 1280, WBA + (size_t)nt * 128 * 1280, 1280, 1280, acc, smem);
      else gemm_kloop(OL + (size_t)mt * 128 * 2048, 2048, WOB + (size_t)nt * 128 * 2048, 2048, 2048, acc, smem);
#pragma unroll
      for (int m = 0; m < 4; ++m) {
        const size_t row = (size_t)(mt * 128 + wr * 64 + m * 16 + fr);
#pragma unroll
        for (int n = 0; n < 4; ++n) {
          u16* ptr = MIX + row * 1024 + nt * 128 + wc * 64 + n * 16 + fq * 4;
          const f32x4 sgm = {bflo(sg[m][n][0]), bfhi(sg[m][n][0]), bflo(sg[m][n][1]), bfhi(sg[m][n][1])};
          f32x4 v = sgm * acc[m][n];
          if (br == 1) { const u32x2 pv = *(const u32x2*)ptr; v = v + (f32x4){bflo(pv.x), bfhi(pv.x), bflo(pv.y), bfhi(pv.y)}; }
          u32x2 w; w.x = pk_bf16(v[0], v[1]); w.y = pk_bf16(v[2], v[3]);
          *(u32x2*)ptr = w;
        }
      }
    }
  }
}

#define PH_PRE PP p = kparams(); unsigned char* ws = p->ws; unsigned char* smem = g_smem; const int l = __builtin_amdgcn_readfirstlane(l_); (void)l; (void)ws; (void)smem; u16* R1 = (u16*)(ws + OFF_R1); (void)R1;
NOINL void ph_pro(int l_) { PH_PRE ln_input(p); convert_weights(p, 0, smem); }
NOINL void ph_k0(int l_) { PH_PRE EpiA1 e{(u16*)(ws + OFF_XL), (u16*)(ws + OFF_G)}; gemm_phase_big(R1, 1024, (const u16*)(ws + OFF_W1), 1024, 1024, 20, e, smem); }
NOINL void ph_k1(int l_) { PH_PRE gates_phase(p, l, smem); }
NOINL void ph_k2(int l_) { PH_PRE scan_summaries(p); }
NOINL void ph_k3(int l_) { PH_PRE scan_final(p); }
NOINL void ph_k4(int l_) { PH_PRE EpiB1 e{(u16*)(ws + OFF_QA), (float*)(ws + OFF_CRAW), (_Float16*)(ws + OFF_QI), (_Float16*)(ws + OFF_KI), (float*)(ws + OFF_WI)};
  gemm_phase_big(R1, 1024, (const u16*)(ws + OFF_W1) + (size_t)2560 * 1024, 1024, 1024, 23, e, smem); }
NOINL void ph_k5(int l_) { PH_PRE ckv_norm(p, l); topk_phase(p, smem); }
NOINL void ph_k6(int l_) { PH_PRE attn_phase(p, l, smem); }
NOINL void ph_k7(int l_) { PH_PRE merge_phase(p, smem); }
NOINL void ph_k8(int l_) { PH_PRE EpiRes e{R1, nullptr}; gemm_phase((const u16*)(ws + OFF_MIX), 1024, (const u16*)(ws + OFF_WO), 1024, 1024, 8, e, smem); }
NOINL void ph_k9(int l_) { PH_PRE ln_rows_inplace(R1, p->in[18] + (size_t)l * 1024, p->in[19] + (size_t)l * 1024, nullptr); }
NOINL void ph_k10(int l_) { PH_PRE EpiUp e{(u16*)(ws + OFF_H), p->in[21] + (size_t)l * 4096}; gemm_phase_big(R1, 1024, (const u16*)(ws + OFF_WUP), 1024, 1024, 32, e, smem); }
NOINL void ph_k11(int l_) { PH_PRE EpiRes e{R1, p->in[23] + (size_t)l * 1024}; gemm_phase((const u16*)(ws + OFF_H), 4096, (const u16*)(ws + OFF_WDN), 4096, 4096, 8, e, smem); }
NOINL void ph_k12(int l_) { PH_PRE ln_rows_inplace(R1, p->in[24] + (size_t)l * 1024, p->in[25] + (size_t)l * 1024, l == 1 ? p->out : nullptr);
  if (l == 0) convert_weights(p, 1, smem); }

#ifndef PROBE_K
#define PROBE_K -1
#endif
DEVI void run_phase(int ph) {
  if (ph == 0) { ph_pro(0); return; }
  const int l = (ph - 1) / NPH_LAYER, k = (ph - 1) % NPH_LAYER;
  if (k == PROBE_K) {
    if (PROBE_K == 10) ph_k10(l);
    if (PROBE_K == 5) ph_k5(l);
    if (PROBE_K == 1) ph_k1(l);
    if (PROBE_K == 2) ph_k2(l);
    if (PROBE_K == 7) ph_k7(l);
    if (PROBE_K == 0) ph_k0(l);
    if (PROBE_K == 6) { PP p = kparams(); attn_phase(p, l, g_smem, true); }
  }
  switch (k) {
    case 0: ph_k0(l); break;
    case 1: ph_k1(l); break;
    case 2: ph_k2(l); break;
    case 3: ph_k3(l); break;
    case 4: ph_k4(l); break;
    case 5: ph_k5(l); break;
    case 6: ph_k6(l); break;
    case 7: ph_k7(l); break;
    case 8: ph_k8(l); break;
    case 9: ph_k9(l); break;
    case 10: ph_k10(l); break;
    case 11: ph_k11(l); break;
    case 12: ph_k12(l); break;
  }
}

__global__ void __launch_bounds__(256, 2) mega_fwd(Params p, int ph_lo, int ph_hi) {
  __shared__ uint4 xb_words;
  cg::grid_group grid = cg::this_grid();
  if (threadIdx.x == 0) xb_words = make_uint4(0u, 0u, 0u, 0u);
  __syncthreads();
  XcdBarrier xb = xcd_barrier_post((unsigned*)(p.ws + OFF_BAR), (volatile LAS unsigned*)&xb_words);
  if (ph_hi < 0) grid.sync();
  for (int ph = ph_lo; ph < ph_hi; ++ph) {
    if (ph > ph_lo) xcd_barrier(xb);
    run_phase(ph);
  }
}

extern "C" void kernel_launch(void* const* d_in, const int* in_sizes, int n_in, void* d_out, int out_size, void* d_ws, size_t ws_size,
                              hipStream_t stream) {
  static int grid_blocks = 0;
  if (!grid_blocks) {
    int dev = 0, cus = 0, per_cu = 0;
    hipGetDevice(&dev);
    hipDeviceGetAttribute(&cus, hipDeviceAttributeMultiprocessorCount, dev);
    hipOccupancyMaxActiveBlocksPerMultiprocessor(&per_cu, mega_fwd, 256, 0);
    if (per_cu < 1) per_cu = 1;
    if (per_cu > 2) per_cu = 2;
    grid_blocks = cus * per_cu;
    if (ws_size < WS_NEED) fprintf(stderr, "kernel_launch: workspace too small: %zu < %zu\n", ws_size, (size_t)WS_NEED);
  }
  if (n_in != 26 || ws_size < WS_NEED) return;
  Params p{};
  for (int i = 0; i < 26; ++i) p.in[i] = (const float*)d_in[i];
  p.out = (float*)d_out;
  p.ws = (unsigned char*)d_ws;
  (void)hipMemsetAsync((unsigned char*)d_ws + OFF_BAR, 0, 16384, stream);
#if MK_PER_PHASE
  for (int ph = 0; ph < NPHASES; ++ph) {
    int lo = ph, hi = ph + 1;
    void* args[] = {&p, &lo, &hi};
    hipLaunchCooperativeKernel((void*)mega_fwd, dim3(grid_blocks), dim3(256), args, 0, stream);
  }
#else
  int lo = 0, hi = NPHASES;
  void* args[] = {&p, &lo, &hi};
  hipError_t e = hipLaunchCooperativeKernel((void*)mega_fwd, dim3(grid_blocks), dim3(256), args, 0, stream);
  if (e != hipSuccess) fprintf(stderr, "cooperative launch failed: %s (grid %d)\n", hipGetErrorString(e), grid_blocks);
#endif
}
```

```cpp
#include <hip/hip_runtime.h>
#include <hip/hip_cooperative_groups.h>
#include <cstdint>
#include <cstdio>
namespace cg = cooperative_groups;

#ifndef MK_PER_PHASE
#define MK_PER_PHASE 0
#endif

typedef unsigned short u16;
typedef short s16x8 __attribute__((ext_vector_type(8)));
typedef short s16x4 __attribute__((ext_vector_type(4)));
typedef _Float16 h16x8 __attribute__((ext_vector_type(8)));
typedef _Float16 h16x4 __attribute__((ext_vector_type(4)));
typedef float f32x4 __attribute__((ext_vector_type(4)));
typedef float f32x16 __attribute__((ext_vector_type(16)));
typedef unsigned u32x4 __attribute__((ext_vector_type(4)));
typedef unsigned u32x2 __attribute__((ext_vector_type(2)));

#define DEVI __device__ __forceinline__

constexpr int T_ = 8208, M_ = 16416, MP = 16512, NMT = 129;
constexpr int DIN = 6472;
constexpr float ALPHA = 1.41421356237f;
constexpr float LN_EPS = 1e-5f;
constexpr float ATT_SCALE = 0.08838834764831845f;
constexpr int NPH_LAYER = 13;
constexpr int NPHASES = 1 + 2 * NPH_LAYER;
constexpr int SMEM_BYTES = 69632;

constexpr size_t OFF_W1 = 0;
constexpr size_t OFF_WG = 11272192;
constexpr size_t OFF_WOB = 15466496;
constexpr size_t OFF_WBA = 19660800;
constexpr size_t OFF_WO = 22282240;
constexpr size_t OFF_WUP = 24379392;
constexpr size_t OFF_WDN = 32768000;
constexpr size_t OFF_WRA = 41156608;
constexpr size_t OFF_WRX = 41484288;
constexpr size_t OFF_R1 = 41811968;
constexpr size_t OFF_BIG = 75628544;
constexpr size_t OFF_XL = OFF_BIG + 0;
constexpr size_t OFF_G = OFF_BIG + 42270720;
constexpr size_t OFF_LA = OFF_BIG + 84541440;
constexpr size_t OFF_U = OFF_BIG + 126812160;
constexpr size_t OFF_SUML = OFF_BIG + 169082880;
constexpr size_t OFF_SUMH = OFF_BIG + 170398720;
constexpr size_t OFF_CRAW = OFF_BIG + 0;
constexpr size_t OFF_QI = OFF_BIG + 16908288;
constexpr size_t OFF_CKV = OFF_BIG + 33816576;
constexpr size_t OFF_QA = OFF_BIG + 84541440;
constexpr size_t OFF_KI = OFF_BIG + 152174592;
constexpr size_t OFF_WI = OFF_BIG + 154288128;
constexpr size_t OFF_SEL = OFF_BIG + 154816512;
constexpr size_t OFF_MIX = OFF_BIG + 0;
constexpr size_t OFF_H = OFF_BIG + 0;
constexpr size_t OFF_BAR = OFF_BIG + 171714560;
constexpr size_t WS_NEED = OFF_BAR + 16384;

struct Params {
  const float* in[26];
  float* out;
  unsigned char* ws;
};

typedef const __attribute__((address_space(4))) Params* PP;
DEVI PP kparams() { return (PP)__builtin_amdgcn_kernarg_segment_ptr(); }
__shared__ __attribute__((aligned(16))) unsigned char g_smem[SMEM_BYTES];
#define NOINL __device__ __forceinline__
DEVI int tid_() { int t = threadIdx.x; asm volatile("" : "+v"(t)); return t; }
DEVI int bid_() { int t = blockIdx.x; asm volatile("" : "+s"(t)); return t; }
DEVI int gdim_() { int t = gridDim.x; asm volatile("" : "+s"(t)); return t; }


#define XB_TMO      128
#define XB_XCNT(j)  (256  + 64 * (j))
#define XB_XSUB(j)  (1280 + 64 * (j))
#define XB_XGEN(j)  (2304 + 64 * (j))
#define XB_TOP      3328
#define XB_TOPGEN   3392
#define XCD_BAR_WORDS 3456
#define XB_SPIN_CAP (1u << 20)
#define LAS __attribute__((address_space(3)))
DEVI unsigned xb_ld(unsigned* p) { return __hip_atomic_load(p, __ATOMIC_RELAXED, __HIP_MEMORY_SCOPE_AGENT); }
DEVI unsigned xb_add(unsigned* p, unsigned v) { return __hip_atomic_fetch_add(p, v, __ATOMIC_RELAXED, __HIP_MEMORY_SCOPE_AGENT); }
DEVI unsigned xb_xcc_id() { return (unsigned)__builtin_amdgcn_s_getreg((3 << 11) | 20) & 0xFu; }
#define XB_SPIN(cond, bar) do { unsigned _sp = 0; while (cond) { \
    if ((++_sp & 255u) == 0u) { if (xb_ld(&(bar)[XB_TMO])) break; if (_sp > XB_SPIN_CAP) { atomicAdd(&(bar)[XB_TMO], 1u); break; } } } } while (0)
struct XcdBarrier { unsigned* bar; unsigned x; volatile LAS unsigned* st; };
DEVI XcdBarrier xcd_barrier_post(unsigned* bar, volatile LAS unsigned* st) {
  XcdBarrier b; b.bar = bar; b.x = xb_xcc_id(); b.st = st;
  if (threadIdx.x == 0) (void)xb_add(&bar[XB_XCNT(b.x)], 1u);
  return b;
}
DEVI void xcd_barrier_complete(unsigned* bar, unsigned x, unsigned& nloc, unsigned& nx) {
  const unsigned G = gridDim.x;
  unsigned sum, cnt, mine, sp = 0u;
  for (;;) {
    sum = 0u; cnt = 0u; mine = 0u;
#pragma unroll
    for (unsigned j = 0; j < 16; ++j) { const unsigned c = xb_ld(&bar[XB_XCNT(j)]); sum += c; cnt += (c > 0u) ? 1u : 0u; mine = (j == x) ? c : mine; }
    if (sum == G) break;
    __builtin_amdgcn_s_sleep(1);
    if ((++sp & 255u) == 0u) { if (xb_ld(&bar[XB_TMO])) break; if (sp > XB_SPIN_CAP) { atomicAdd(&bar[XB_TMO], 1u); break; } }
  }
  nloc = mine > 0u ? mine : 1u; nx = cnt > 0u ? cnt : 1u;
}
DEVI void xcd_barrier(const XcdBarrier& b) {
  asm volatile("s_waitcnt vmcnt(0)" ::: "memory");
  __syncthreads();
  if (threadIdx.x == 0) {
    unsigned* bar = b.bar;
    __builtin_amdgcn_s_waitcnt(0);
    unsigned nloc = b.st[0], nx = b.st[1];
    if (nloc == 0u) { xcd_barrier_complete(bar, b.x, nloc, nx); b.st[0] = nloc; b.st[1] = nx; }
    const unsigned old = xb_add(&bar[XB_XSUB(b.x)], 1u);
    const unsigned gen = old / nloc;
    if (old + 1u == (gen + 1u) * nloc) {
      __builtin_amdgcn_fence(__ATOMIC_RELEASE, "agent");
      asm volatile("s_waitcnt vmcnt(0)" ::: "memory");
      const unsigned og = xb_add(&bar[XB_TOP], 1u);
      const unsigned tg = og / nx;
      if (og + 1u == (tg + 1u) * nx) xb_add(&bar[XB_TOPGEN], 1u);
      else XB_SPIN(xb_ld(&bar[XB_TOPGEN]) == tg, bar);
      __builtin_amdgcn_fence(__ATOMIC_ACQUIRE, "agent");
      xb_add(&bar[XB_XGEN(b.x)], 1u);
      asm volatile("s_waitcnt vmcnt(0)" ::: "memory");
    } else {
      XB_SPIN(xb_ld(&bar[XB_XGEN(b.x)]) == gen, bar);
      __builtin_amdgcn_fence(__ATOMIC_ACQUIRE, "agent");
      asm volatile("s_waitcnt vmcnt(0)" ::: "memory");
    }
  }
  __syncthreads();
}

DEVI float bf2f(u16 h) { return __uint_as_float(((unsigned)h) << 16); }
DEVI float bflo(unsigned w) { return __uint_as_float(w << 16); }
DEVI float bfhi(unsigned w) { return __uint_as_float(w & 0xffff0000u); }
DEVI unsigned pk_bf16(float lo, float hi) { unsigned r; asm("s_nop 1\n\tv_cvt_pk_bf16_f32 %0, %1, %2" : "=v"(r) : "v"(lo), "v"(hi)); return r; }
DEVI float sigmoidf_(float x) { return __builtin_amdgcn_rcpf(1.f + __expf(-x)); }
DEVI float gelu_tanh(float x) {
  const float y = 0.7978845608028654f * (x + 0.044715f * x * x * x);
  const float th = 1.f - 2.f * __builtin_amdgcn_rcpf(__expf(2.f * y) + 1.f);
  return 0.5f * x * (1.f + th);
}
DEVI float wave_sum(float v) {
#pragma unroll
  for (int o = 32; o > 0; o >>= 1) v += __shfl_xor(v, o);
  return v;
}
DEVI float wave_max(float v) {
#pragma unroll
  for (int o = 32; o > 0; o >>= 1) v = fmaxf(v, __shfl_xor(v, o));
  return v;
}

DEVI int swz(int row, int ch) { return row * 128 + ((ch ^ ((row >> 1) & 7)) << 4); }

DEVI void gemm_kloop(const u16* __restrict__ A, int lda, const u16* __restrict__ Bt, int ldb, int K, f32x4 (&acc)[4][4], unsigned char* smem) {
  const int tid = tid_(), lane = tid & 63, wid = tid >> 6, wr = wid >> 1, wc = wid & 1, fr = lane & 15, fq = lane >> 4;
  u32x4 r0a[4], r0b[4], r1a[4], r1b[4];
  const int nt = K >> 6;
  const int srow = tid >> 3, sch = tid & 7;
  const u16* ap = A + (size_t)srow * lda + sch * 8;
  const u16* bp = Bt + (size_t)srow * ldb + sch * 8;
#define G_LOAD(RA, RB, T) { const int ko_ = min((T), nt - 1) * 64; _Pragma("unroll") for (int i = 0; i < 4; ++i) { RA[i] = *(const u32x4*)(ap + (size_t)(32 * i) * lda + ko_); RB[i] = *(const u32x4*)(bp + (size_t)(32 * i) * ldb + ko_); } }
#define G_STORE(RA, RB, BUF) { _Pragma("unroll") for (int i = 0; i < 4; ++i) { *(u32x4*)((BUF) + swz(srow + 32 * i, sch)) = RA[i]; *(u32x4*)((BUF) + 16384 + swz(srow + 32 * i, sch)) = RB[i]; } }
#define G_COMPUTE(BUF) { _Pragma("unroll") for (int ks = 0; ks < 2; ++ks) { s16x8 af[4], bfr[4]; \
    _Pragma("unroll") for (int m = 0; m < 4; ++m) af[m] = *(const s16x8*)((BUF) + swz(wr * 64 + m * 16 + fr, ks * 4 + fq)); \
    _Pragma("unroll") for (int n = 0; n < 4; ++n) bfr[n] = *(const s16x8*)((BUF) + 16384 + swz(wc * 64 + n * 16 + fr, ks * 4 + fq)); \
    _Pragma("unroll") for (int m = 0; m < 4; ++m) _Pragma("unroll") for (int n = 0; n < 4; ++n) acc[m][n] = __builtin_amdgcn_mfma_f32_16x16x32_bf16(bfr[n], af[m], acc[m][n], 0, 0, 0); } }
  unsigned char* buf0 = smem; unsigned char* buf1 = smem + 32768;
  G_LOAD(r0a, r0b, 0);
  G_LOAD(r1a, r1b, 1);
  __syncthreads();
  G_STORE(r0a, r0b, buf0);
  G_LOAD(r0a, r0b, 2);
  __syncthreads();
#pragma unroll 1
  for (int t = 0; t < nt; t += 2) {
    G_COMPUTE(buf0);
    G_STORE(r1a, r1b, buf1);
    G_LOAD(r1a, r1b, t + 3);
    __syncthreads();
    G_COMPUTE(buf1);
    G_STORE(r0a, r0b, buf0);
    G_LOAD(r0a, r0b, t + 4);
    __syncthreads();
  }
#undef G_LOAD
#undef G_STORE
#undef G_COMPUTE
}

DEVI void zero_acc(f32x4 (&acc)[4][4]) {
#pragma unroll
  for (int m = 0; m < 4; ++m)
#pragma unroll
    for (int n = 0; n < 4; ++n) acc[m][n] = (f32x4){0.f, 0.f, 0.f, 0.f};
}


struct TileIter {
  int x, j, J, cm, nNt, u, total; bool xcd;
  DEVI void init(int nNt_) {
    const int G = gdim_(), b = bid_();
    nNt = nNt_; xcd = (G & 7) == 0;
    if (xcd) { x = b & 7; j = b >> 3; J = G >> 3; cm = (NMT - x + 7) >> 3; total = cm * nNt; }
    else { x = 0; j = b; J = G; cm = NMT; total = NMT * nNt; }
    u = j;
  }
  DEVI bool next(int& mt, int& nt) {
    if (u >= total) return false;
    if (xcd) {
      const int per_g = 8 * nNt, g = u / per_g, v = u - g * per_g;
      const int gm = min(8, cm - 8 * g);
      nt = v / gm; const int mi = v - nt * gm;
      mt = x + 8 * (8 * g + mi);
    } else { nt = u / NMT; mt = u - nt * NMT; }
    u += J;
    return true;
  }
};


template <class Epi>
DEVI void gemm_phase(const u16* A, int lda, const u16* Bt, int ldb, int K, int nNt, const Epi& epi, unsigned char* smem) {
  TileIter ti; ti.init(nNt);
  int mt, nt;
  const int wid = tid_() >> 6, wr = wid >> 1;
  while (ti.next(mt, nt)) {
    f32x4 acc[4][4];
    zero_acc(acc);
    gemm_kloop(A + (size_t)mt * 128 * lda, lda, Bt + (size_t)nt * 128 * ldb, ldb, K, acc, smem);
    epi(acc, mt * 128 + wr * 64, nt);
  }
}

constexpr int NMT2 = 65;
DEVI void gemm_kloop_big(const u16* __restrict__ A, int lda, const u16* __restrict__ Bt, int ldb, int K, f32x4 (&acc)[8][4], unsigned char* smem) {
  const int tid = tid_(), lane = tid & 63, wid = tid >> 6, wr = wid >> 1, wc = wid & 1, fr = lane & 15, fq = lane >> 4;
  u32x4 ra[8], rb[4];
  const int nt = K >> 6;
  const int srow = tid >> 3, sch = tid & 7;
  const u16* ap = A + (size_t)srow * lda + sch * 8;
  const u16* bp = Bt + (size_t)srow * ldb + sch * 8;
  unsigned char* sa = smem; unsigned char* sb = smem + 32768;
#pragma unroll
  for (int i = 0; i < 8; ++i) ra[i] = *(const u32x4*)(ap + (size_t)(32 * i) * lda);
#pragma unroll
  for (int i = 0; i < 4; ++i) rb[i] = *(const u32x4*)(bp + (size_t)(32 * i) * ldb);
  __syncthreads();
#pragma unroll 1
  for (int t = 0; t < nt; ++t) {
#pragma unroll
    for (int i = 0; i < 8; ++i) *(u32x4*)(sa + swz(srow + 32 * i, sch)) = ra[i];
#pragma unroll
    for (int i = 0; i < 4; ++i) *(u32x4*)(sb + swz(srow + 32 * i, sch)) = rb[i];
    __syncthreads();
    {
      const int ko = min(t + 1, nt - 1) * 64;
#pragma unroll
      for (int i = 0; i < 8; ++i) ra[i] = *(const u32x4*)(ap + (size_t)(32 * i) * lda + ko);
#pragma unroll
      for (int i = 0; i < 4; ++i) rb[i] = *(const u32x4*)(bp + (size_t)(32 * i) * ldb + ko);
    }
#pragma unroll
    for (int ks = 0; ks < 2; ++ks) {
      s16x8 bfr[4];
#pragma unroll
      for (int n = 0; n < 4; ++n) bfr[n] = *(const s16x8*)(sb + swz(wc * 64 + n * 16 + fr, ks * 4 + fq));
#pragma unroll
      for (int mh = 0; mh < 2; ++mh) {
        s16x8 af[4];
#pragma unroll
        for (int m = 0; m < 4; ++m) af[m] = *(const s16x8*)(sa + swz(wr * 128 + mh * 64 + m * 16 + fr, ks * 4 + fq));
#pragma unroll
        for (int m = 0; m < 4; ++m)
#pragma unroll
          for (int n = 0; n < 4; ++n) acc[mh * 4 + m][n] = __builtin_amdgcn_mfma_f32_16x16x32_bf16(bfr[n], af[m], acc[mh * 4 + m][n], 0, 0, 0);
      }
    }
    __syncthreads();
  }
}

template <class Epi>
DEVI void gemm_phase_big(const u16* A, int lda, const u16* Bt, int ldb, int K, int nNt, const Epi& epi, unsigned char* smem) {
  const int G = gdim_(), b = bid_();
  const bool xcd = (G & 7) == 0;
  const int x = xcd ? (b & 7) : 0, j = xcd ? (b >> 3) : b, J = xcd ? (G >> 3) : G;
  const int cm = xcd ? 8 : 64;
  const int total = cm * nNt;
  const int wid = tid_() >> 6, wr = wid >> 1;
#pragma unroll 1
  for (int u = j; u < total; u += J) {
    int mt, nt;
    if (xcd) { nt = u >> 3; mt = x + 8 * (u & 7); }
    else { nt = u >> 6; mt = u & 63; }
    f32x4 acc[8][4];
#pragma unroll
    for (int m = 0; m < 8; ++m)
#pragma unroll
      for (int n = 0; n < 4; ++n) acc[m][n] = (f32x4){0.f, 0.f, 0.f, 0.f};
    gemm_kloop_big(A + (size_t)mt * 256 * lda, lda, Bt + (size_t)nt * 128 * ldb, ldb, K, acc, smem);
    const int rb0 = mt * 256 + wr * 128;
    epi(*(const f32x4(*)[4][4])&acc[0], rb0, nt);
    epi(*(const f32x4(*)[4][4])&acc[4], rb0 + 64, nt);
  }
  const int step = xcd ? 8 : 1;
#pragma unroll 1
  for (int e = J - 1 - j, nt = x + step * e; nt < nNt; e += J, nt += step * J) {
    f32x4 acc[4][4];
    zero_acc(acc);
    gemm_kloop(A + (size_t)16384 * lda, lda, Bt + (size_t)nt * 128 * ldb, ldb, K, acc, smem);
    epi(acc, 16384 + wr * 64, nt);
  }
}

#define EPI_IDX const int tid = tid_(), lane = tid & 63, wid = tid >> 6, wr = wid >> 1, wc = wid & 1, fr = lane & 15, fq = lane >> 4; (void)wr; (void)wc; (void)fr; (void)fq;

DEVI void wave_tile_store_bf16(const u32x2 (&w)[4][4], u16* dst  , int ld, int lds_off = 0) {
  const int tid = tid_(), lane = tid & 63, wid = tid >> 6, fr = lane & 15, fq = lane >> 4;
  unsigned char* st = g_smem + lds_off + wid * 8192;
#pragma unroll
  for (int m = 0; m < 4; ++m)
#pragma unroll
    for (int n = 0; n < 4; ++n) *(u32x2*)(st + (m * 16 + fr) * 128 + (((n * 4 + fq) ^ fr) << 3)) = w[m][n];
  const int c = lane & 7;
#pragma unroll
  for (int i = 0; i < 8; ++i) {
    const int rl = (lane >> 3) + 8 * i, r15 = rl & 15;
    u32x4 q = *(const u32x4*)(st + rl * 128 + ((c ^ (r15 >> 1)) << 4));
    if (r15 & 1) q = (u32x4){q.z, q.w, q.x, q.y};
    *(u32x4*)(dst + (size_t)rl * ld + c * 8) = q;
  }
}

struct EpiA1 {
  u16* XL; u16* G;
  DEVI void operator()(const f32x4 (&acc)[4][4], int rowbase, int nt) const {
    EPI_IDX
    const bool isg = nt >= 10;
    u16* dst = isg ? G : XL;
    u32x2 w[4][4];
#pragma unroll
    for (int m = 0; m < 4; ++m)
#pragma unroll
      for (int n = 0; n < 4; ++n) {
        f32x4 v = acc[m][n];
        if (isg) { v[0] = gelu_tanh(v[0]); v[1] = gelu_tanh(v[1]); v[2] = gelu_tanh(v[2]); v[3] = gelu_tanh(v[3]); }
        w[m][n].x = pk_bf16(v[0], v[1]); w[m][n].y = pk_bf16(v[2], v[3]);
      }
    wave_tile_store_bf16(w, dst + (size_t)rowbase * 1280 + (isg ? nt - 10 : nt) * 128 + wc * 64, 1280);
  }
};

struct EpiB1 {
  u16* QA; float* CRAW; _Float16* QI; _Float16* KI; float* WI;
  DEVI void operator()(const f32x4 (&acc)[4][4], int rowbase, int nt) const {
    EPI_IDX
    if (nt < 16 || (nt >= 18 && nt < 22)) {
      u32x2 w[4][4];
#pragma unroll
      for (int m = 0; m < 4; ++m)
#pragma unroll
        for (int n = 0; n < 4; ++n) {
          const f32x4 v = acc[m][n];
          if (nt < 16) { w[m][n].x = pk_bf16(v[0], v[1]); w[m][n].y = pk_bf16(v[2], v[3]); }
          else { union { h16x4 h; u32x2 u; } cv; cv.h[0] = (_Float16)v[0]; cv.h[1] = (_Float16)v[1]; cv.h[2] = (_Float16)v[2]; cv.h[3] = (_Float16)v[3]; w[m][n] = cv.u; }
        }
      if (nt < 16) wave_tile_store_bf16(w, QA + (size_t)rowbase * 2048 + nt * 128 + wc * 64, 2048);
      else wave_tile_store_bf16(w, (u16*)QI + (size_t)rowbase * 512 + (nt - 18) * 128 + wc * 64, 512);
      return;
    }
#pragma unroll
    for (int m = 0; m < 4; ++m) {
      const size_t row = (size_t)(rowbase + m * 16 + fr);
      if (nt < 16) {
      } else if (nt < 18) {
#pragma unroll
        for (int n = 0; n < 4; ++n) *(f32x4*)(CRAW + row * 256 + (nt - 16) * 128 + wc * 64 + n * 16 + fq * 4) = acc[m][n];
      } else if (nt < 22) {
      } else {
        if (wc == 0) {
          float s = 0.f;
#pragma unroll
          for (int n = 0; n < 4; ++n) s += (acc[m][n][0] + acc[m][n][1]) + (acc[m][n][2] + acc[m][n][3]);
          s += __shfl_xor(s, 16); s += __shfl_xor(s, 32);
          const float mu = s * (1.f / 64.f);
          float q = 0.f;
#pragma unroll
          for (int n = 0; n < 4; ++n)
#pragma unroll
            for (int j = 0; j < 4; ++j) { const float d = acc[m][n][j] - mu; q += d * d; }
          q += __shfl_xor(q, 16); q += __shfl_xor(q, 32);
          const float rs = rsqrtf(q * (1.f / 64.f) + LN_EPS);
#pragma unroll
          for (int n = 0; n < 4; ++n) {
            h16x4 h;
#pragma unroll
            for (int j = 0; j < 4; ++j) h[j] = (_Float16)((acc[m][n][j] - mu) * rs);
            *(h16x4*)(KI + row * 64 + n * 16 + fq * 4) = h;
          }
        } else if (fq < 2) {
          f32x4 v = acc[m][0] * 0.044194173824159216f;
          *(f32x4*)(WI + row * 8 + fq * 4) = v;
        }
      }
    }
  }
};

struct EpiRes {
  u16* R1; const float* bias;
  DEVI void operator()(const f32x4 (&acc)[4][4], int rowbase, int nt) const {
    EPI_IDX
    unsigned char* st = g_smem + wid * 16384;
#pragma unroll
    for (int m = 0; m < 4; ++m)
#pragma unroll
      for (int n = 0; n < 4; ++n) *(f32x4*)(st + (m * 16 + fr) * 256 + (((n * 4 + fq) ^ fr) << 4)) = acc[m][n];
    const int c = lane & 7;
    const int col0 = nt * 128 + wc * 64 + c * 8;
    f32x4 b0 = (f32x4){0.f, 0.f, 0.f, 0.f}, b1 = (f32x4){0.f, 0.f, 0.f, 0.f};
    if (bias) { b0 = *(const f32x4*)(bias + col0); b1 = *(const f32x4*)(bias + col0 + 4); }
#pragma unroll
    for (int i = 0; i < 8; ++i) {
      const int rl = (lane >> 3) + 8 * i, r15 = rl & 15;
      const f32x4 a0 = *(const f32x4*)(st + rl * 256 + (((2 * c) ^ r15) << 4));
      const f32x4 a1 = *(const f32x4*)(st + rl * 256 + (((2 * c + 1) ^ r15) << 4));
      u16* ptr = R1 + (size_t)(rowbase + rl) * 1024 + col0;
      const u32x4 x = *(const u32x4*)ptr;
      u32x4 w;
      w.x = pk_bf16(ALPHA * bflo(x.x) + a0[0] + b0[0], ALPHA * bfhi(x.x) + a0[1] + b0[1]);
      w.y = pk_bf16(ALPHA * bflo(x.y) + a0[2] + b0[2], ALPHA * bfhi(x.y) + a0[3] + b0[3]);
      w.z = pk_bf16(ALPHA * bflo(x.z) + a1[0] + b1[0], ALPHA * bfhi(x.z) + a1[1] + b1[1]);
      w.w = pk_bf16(ALPHA * bflo(x.w) + a1[2] + b1[2], ALPHA * bfhi(x.w) + a1[3] + b1[3]);
      *(u32x4*)ptr = w;
    }
  }
};

struct EpiUp {
  u16* H; const float* bias;
  DEVI void operator()(const f32x4 (&acc)[4][4], int rowbase, int nt) const {
    EPI_IDX
    u32x2 w[4][4];
#pragma unroll
    for (int n = 0; n < 4; ++n) {
      const int col = nt * 128 + wc * 64 + n * 16 + fq * 4;
      const f32x4 b = *(const f32x4*)(bias + col);
#pragma unroll
      for (int m = 0; m < 4; ++m) {
        f32x4 v = acc[m][n] + b;
#pragma unroll
        for (int j = 0; j < 4; ++j) { const float r = fmaxf(v[j], 0.f); v[j] = r * r; }
        w[m][n].x = pk_bf16(v[0], v[1]); w[m][n].y = pk_bf16(v[2], v[3]);
      }
    }
    wave_tile_store_bf16(w, H + (size_t)rowbase * 4096 + nt * 128 + wc * 64, 4096);
  }
};

DEVI void tr_job(const float* src, int lds_, int nvalid, u16* dst, int ldd, int K, int Npad, float* sm) {
  const int tid = tid_();
  const int nkt = K >> 6, nnt = Npad >> 6, ntl = nkt * nnt;
#pragma unroll 1
  for (int tile = bid_(); tile < ntl; tile += gdim_()) {
    const int ntile = tile / nkt, kt = tile - ntile * nkt;
    const int k0 = kt * 64, n0 = ntile * 64;
    __syncthreads();
#pragma unroll 16
    for (int it = 0; it < 16; ++it) {
      const int idx = tid + 256 * it, kk = idx >> 6, nn = idx & 63;
      float v = 0.f;
      if (n0 + nn < nvalid) v = src[(size_t)(k0 + kk) * lds_ + n0 + nn];
      sm[kk * 65 + nn] = v;
    }
    __syncthreads();
#pragma unroll 8
    for (int it = 0; it < 8; ++it) {
      const int idx = tid + 256 * it, nn = idx >> 5, kp = idx & 31;
      const unsigned w = pk_bf16(sm[(2 * kp) * 65 + nn], sm[(2 * kp + 1) * 65 + nn]);
      *(unsigned*)(dst + (size_t)(n0 + nn) * ldd + k0 + 2 * kp) = w;
    }
  }
}

DEVI void fold_tile(const float* L, int lsa, int lsd, const float* R, int rs, u16* dst, int ldd, float* sm) {
  const int tid = tid_();
  float* sL = sm; float* sR = sm + 64 * 129;
  __syncthreads();
  if (lsd == 1) {
#pragma unroll 16
    for (int it = 0; it < 32; ++it) { const int idx = tid + 256 * it, a = idx >> 7, d = idx & 127; sL[a * 129 + d] = L[(size_t)a * lsa + d]; }
  } else {
#pragma unroll 16
    for (int it = 0; it < 32; ++it) { const int idx = tid + 256 * it, a = idx & 63, d = idx >> 6; sL[a * 129 + d] = L[(size_t)a * lsa + (size_t)d * lsd]; }
  }
#pragma unroll 16
  for (int it = 0; it < 32; ++it) { const int idx = tid + 256 * it, b = idx >> 7, d = idx & 127; sR[b * 129 + d] = R[(size_t)b * rs + d]; }
  __syncthreads();
  const int ty = tid >> 4, tx = tid & 15;
  float o[4][4];
#pragma unroll
  for (int i = 0; i < 4; ++i)
#pragma unroll
    for (int j = 0; j < 4; ++j) o[i][j] = 0.f;
#pragma unroll 2
  for (int d = 0; d < 128; ++d) {
    float l[4], r[4];
#pragma unroll
    for (int i = 0; i < 4; ++i) l[i] = sL[(ty * 4 + i) * 129 + d];
#pragma unroll
    for (int j = 0; j < 4; ++j) r[j] = sR[(tx + 16 * j) * 129 + d];
#pragma unroll
    for (int i = 0; i < 4; ++i)
#pragma unroll
      for (int j = 0; j < 4; ++j) o[i][j] = fmaf(l[i], r[j], o[i][j]);
  }
#pragma unroll
  for (int i = 0; i < 4; ++i)
#pragma unroll
    for (int j = 0; j < 4; ++j) dst[(size_t)(ty * 4 + i) * ldd + tx + 16 * j] = (u16)(pk_bf16(o[i][j], 0.f) & 0xffff);
}

DEVI void convert_weights(PP p, int l, unsigned char* smem) {
  float* sm = (float*)smem;
  unsigned char* ws = p->ws;
  const float* w_in = p->in[4] + (size_t)l * 1024 * DIN;
  u16* W1 = (u16*)(ws + OFF_W1);
  tr_job(w_in, DIN, 2560, W1, 1024, 1024, 2560, sm);
  tr_job(w_in + 3584, DIN, 840, W1 + (size_t)4608 * 1024, 1024, 1024, 896, sm);
  tr_job(w_in + 4424, DIN, 2048, (u16*)(ws + OFF_WG), 1024, 1024, 2048, sm);
  tr_job(p->in[15] + (size_t)l * 1280 * 1024, 1024, 1024, (u16*)(ws + OFF_WBA), 1280, 1280, 1024, sm);
  tr_job(p->in[17] + (size_t)l * 1024 * 1024, 1024, 1024, (u16*)(ws + OFF_WO), 1024, 1024, 1024, sm);
  tr_job(p->in[20] + (size_t)l * 1024 * 4096, 4096, 4096, (u16*)(ws + OFF_WUP), 1024, 1024, 4096, sm);
  tr_job(p->in[22] + (size_t)l * 4096 * 1024, 1024, 1024, (u16*)(ws + OFF_WDN), 4096, 4096, 1024, sm);
#pragma unroll 1
  for (int nb = 0; nb < 10; ++nb) {
    tr_job(p->in[7] + (size_t)l * 163840 + nb * 16384, 128, 128, (u16*)(ws + OFF_WRA) + nb * 16384, 128, 128, 128, sm);
    tr_job(p->in[9] + (size_t)l * 163840 + nb * 16384, 128, 128, (u16*)(ws + OFF_WRX) + nb * 16384, 128, 128, 128, sm);
  }
  const float* w_uk = p->in[13] + (size_t)l * 8 * 256 * 128;
  const float* w_uv = p->in[14] + (size_t)l * 8 * 256 * 128;
  const float* w_bb = p->in[16] + (size_t)l * 1024 * 1024;
  u16* WOB = (u16*)(ws + OFF_WOB);
#pragma unroll 1
  for (int it = bid_(); it < 1024; it += gdim_()) {
    if (it < 512) {
      const int h = it >> 6, rt = (it >> 4) & 3, kt = it & 15;
      fold_tile(w_uk + ((size_t)h * 256 + rt * 64) * 128, 128, 1, w_in + (size_t)(kt * 64) * DIN + 2560 + h * 128, DIN,
                W1 + (size_t)(2560 + h * 256 + rt * 64) * 1024 + kt * 64, 1024, sm);
    } else {
      const int j = it - 512, h = j >> 6, ntile = (j >> 2) & 15, rt = j & 3;
      fold_tile(w_bb + (size_t)(128 * h) * 1024 + ntile * 64, 1, 1024, w_uv + ((size_t)h * 256 + rt * 64) * 128, 128,
                WOB + (size_t)(ntile * 64) * 2048 + h * 256 + rt * 64, 2048, sm);
    }
  }
}

DEVI void ln_rows_inplace(u16* R1, const float* g, const float* b, float* out  ) {
  const int lane = tid_() & 63, wid = tid_() >> 6;
  const int stride = gdim_() * 4;
  float gv[16], bv[16];
#pragma unroll
  for (int k = 0; k < 4; ++k) {
    const f32x4 g0 = *(const f32x4*)(g + 256 * k + lane * 4), b0 = *(const f32x4*)(b + 256 * k + lane * 4);
#pragma unroll
    for (int j = 0; j < 4; ++j) { gv[4 * k + j] = g0[j]; bv[4 * k + j] = b0[j]; }
  }
  int row = bid_() * 4 + wid;
  u32x2 x[4];
#pragma unroll
  for (int k = 0; k < 4; ++k) x[k] = (u32x2){0u, 0u};
  if (row < M_) {
    const u16* rp0 = R1 + (size_t)row * 1024 + lane * 4;
#pragma unroll
    for (int k = 0; k < 4; ++k) x[k] = *(const u32x2*)(rp0 + 256 * k);
  }
  for (; row < M_; row += stride) {
    u16* rp = R1 + (size_t)row * 1024 + lane * 4;
    const u16* np = R1 + (size_t)min(row + stride, M_ - 1) * 1024 + lane * 4;
    u32x2 nx[4];
#pragma unroll
    for (int k = 0; k < 4; ++k) nx[k] = *(const u32x2*)(np + 256 * k);
    float v[16];
#pragma unroll
    for (int k = 0; k < 4; ++k) { v[4 * k] = bflo(x[k].x); v[4 * k + 1] = bfhi(x[k].x); v[4 * k + 2] = bflo(x[k].y); v[4 * k + 3] = bfhi(x[k].y); }
    float s = 0.f;
#pragma unroll
    for (int j = 0; j < 16; ++j) s += v[j];
    const float mu = wave_sum(s) * (1.f / 1024.f);
    float q = 0.f;
#pragma unroll
    for (int j = 0; j < 16; ++j) { const float d = v[j] - mu; q += d * d; }
    const float rs = rsqrtf(wave_sum(q) * (1.f / 1024.f) + LN_EPS);
    float y[16];
#pragma unroll
    for (int j = 0; j < 16; ++j) y[j] = (v[j] - mu) * rs * gv[j] + bv[j];
    if (out) {
      const int bb = row >= T_ ? 1 : 0, t = row - bb * T_;
      if (t >= 16) {
        float* op = out + ((size_t)bb * 8192 + (t - 16)) * 1024 + lane * 4;
#pragma unroll
        for (int k = 0; k < 4; ++k) *(f32x4*)(op + 256 * k) = (f32x4){y[4 * k], y[4 * k + 1], y[4 * k + 2], y[4 * k + 3]};
      }
    } else {
#pragma unroll
      for (int k = 0; k < 4; ++k) { u32x2 w; w.x = pk_bf16(y[4 * k], y[4 * k + 1]); w.y = pk_bf16(y[4 * k + 2], y[4 * k + 3]); *(u32x2*)(rp + 256 * k) = w; }
    }
#pragma unroll
    for (int k = 0; k < 4; ++k) x[k] = nx[k];
  }
}

DEVI void ln_input(PP p) {
  const int lane = tid_() & 63, wid = tid_() >> 6;
  u16* R1 = (u16*)(p->ws + OFF_R1);
  const float* g = p->in[2]; const float* b = p->in[3];
  float gv[16], bv[16];
#pragma unroll
  for (int k = 0; k < 4; ++k) {
    const f32x4 g0 = *(const f32x4*)(g + 256 * k + lane * 4), b0 = *(const f32x4*)(b + 256 * k + lane * 4);
#pragma unroll
    for (int j = 0; j < 4; ++j) { gv[4 * k + j] = g0[j]; bv[4 * k + j] = b0[j]; }
  }
  for (int row = bid_() * 4 + wid; row < MP; row += gdim_() * 4) {
    u16* rp = R1 + (size_t)row * 1024 + lane * 4;
    if (row >= M_) {
      unsigned z = 0; asm volatile("" : "+v"(z));
#pragma unroll
      for (int k = 0; k < 4; ++k) *(u32x2*)(rp + 256 * k) = (u32x2){z, z};
      continue;
    }
    const int bb = row >= T_ ? 1 : 0, t = row - bb * T_;
    const float* src = (t < 16 ? p->in[1] + (size_t)t * 1024 : p->in[0] + ((size_t)bb * 8192 + (t - 16)) * 1024) + lane * 4;
    float v[16];
#pragma unroll
    for (int k = 0; k < 4; ++k) {
      const f32x4 a0 = *(const f32x4*)(src + 256 * k);
#pragma unroll
      for (int j = 0; j < 4; ++j) v[4 * k + j] = a0[j];
    }
    float s = 0.f;
#pragma unroll
    for (int j = 0; j < 16; ++j) s += v[j];
    const float mu = wave_sum(s) * (1.f / 1024.f);
    float q = 0.f;
#pragma unroll
    for (int j = 0; j < 16; ++j) { const float d = v[j] - mu; q += d * d; }
    const float rs = rsqrtf(wave_sum(q) * (1.f / 1024.f) + LN_EPS);
#pragma unroll
    for (int k = 0; k < 4; ++k) {
      float y[4];
#pragma unroll
      for (int j = 0; j < 4; ++j) y[j] = (v[4 * k + j] - mu) * rs * gv[4 * k + j] + bv[4 * k + j];
      u32x2 w; w.x = pk_bf16(y[0], y[1]); w.y = pk_bf16(y[2], y[3]);
      *(u32x2*)(rp + 256 * k) = w;
    }
  }
}

DEVI void gates_phase(PP p, int l, unsigned char* smem) {
  EPI_IDX
  unsigned char* ws = p->ws;
  const u16* XL = (const u16*)(ws + OFF_XL);
  u16* LA = (u16*)(ws + OFF_LA); u16* U = (u16*)(ws + OFF_U);
  const float* conv_w = p->in[5] + (size_t)l * 4 * 1280; const float* conv_b = p->in[6] + (size_t)l * 1280;
  const float* b_a = p->in[8] + (size_t)l * 1280; const float* b_x = p->in[10] + (size_t)l * 1280; const float* lam = p->in[11] + (size_t)l * 1280;
  unsigned char* sA = smem; unsigned char* sB = smem + 32768;
  TileIter ti; ti.init(10);
  int mt, nb;
  while (ti.next(mt, nb)) {
    const int r0 = mt * 128, ch0 = nb * 128;
    __syncthreads();
#pragma unroll 4
    for (int it = 0; it < 8; ++it) {
      const int idx = tid + 256 * it, row = idx >> 4, cc = idx & 15;
      const int R = r0 + row, ch = ch0 + cc * 8;
      float a[8];
      const f32x4 cb0 = *(const f32x4*)(conv_b + ch), cb1 = *(const f32x4*)(conv_b + ch + 4);
#pragma unroll
      for (int j = 0; j < 4; ++j) { a[j] = cb0[j]; a[4 + j] = cb1[j]; }
      if (R < M_) {
        const int t = R >= T_ ? R - T_ : R;
#pragma unroll
        for (int j = 0; j < 4; ++j) {
          if (t - 3 + j >= 0) {
            const u32x4 x = *(const u32x4*)(XL + (size_t)(R - 3 + j) * 1280 + ch);
            const f32x4 w0 = *(const f32x4*)(conv_w + j * 1280 + ch), w1 = *(const f32x4*)(conv_w + j * 1280 + ch + 4);
            a[0] = fmaf(w0[0], bflo(x[0]), a[0]); a[1] = fmaf(w0[1], bfhi(x[0]), a[1]);
            a[2] = fmaf(w0[2], bflo(x[1]), a[2]); a[3] = fmaf(w0[3], bfhi(x[1]), a[3]);
            a[4] = fmaf(w1[0], bflo(x[2]), a[4]); a[5] = fmaf(w1[1], bfhi(x[2]), a[5]);
            a[6] = fmaf(w1[2], bflo(x[3]), a[6]); a[7] = fmaf(w1[3], bfhi(x[3]), a[7]);
          }
        }
      } else {
#pragma unroll
        for (int j = 0; j < 8; ++j) a[j] = 0.f;
      }
      u32x4 w;
#pragma unroll
      for (int j = 0; j < 4; ++j) w[j] = pk_bf16(a[2 * j], a[2 * j + 1]);
      *(u32x4*)(sA + (cc >> 3) * 16384 + swz(row, cc & 7)) = w;
    }
    f32x4 acci[4][4];
    unsigned rpk[4][4][2];
#pragma unroll
    for (int pass = 0; pass < 2; ++pass) {
      const u16* Wt = (const u16*)(ws + (pass ? OFF_WRX : OFF_WRA)) + nb * 16384;
      if (pass) __syncthreads();
#pragma unroll 8
      for (int it = 0; it < 8; ++it) {
        const int idx = tid + 256 * it, row = idx >> 4, cc = idx & 15;
        *(u32x4*)(sB + (cc >> 3) * 16384 + swz(row, cc & 7)) = *(const u32x4*)(Wt + row * 128 + cc * 8);
      }
      __syncthreads();
      zero_acc(acci);
#pragma unroll
      for (int kt = 0; kt < 2; ++kt)
#pragma unroll
        for (int ks = 0; ks < 2; ++ks) {
          s16x8 af[4], bfr[4];
#pragma unroll
          for (int m = 0; m < 4; ++m) af[m] = *(const s16x8*)(sA + kt * 16384 + swz(wr * 64 + m * 16 + fr, ks * 4 + fq));
#pragma unroll
          for (int n = 0; n < 4; ++n) bfr[n] = *(const s16x8*)(sB + kt * 16384 + swz(wc * 64 + n * 16 + fr, ks * 4 + fq));
#pragma unroll
          for (int m = 0; m < 4; ++m)
#pragma unroll
            for (int n = 0; n < 4; ++n) acci[m][n] = __builtin_amdgcn_mfma_f32_16x16x32_bf16(bfr[n], af[m], acci[m][n], 0, 0, 0);
        }
      if (pass == 0) {
#pragma unroll
        for (int n = 0; n < 4; ++n) {
          const f32x4 ba = *(const f32x4*)(b_a + ch0 + wc * 64 + n * 16 + fq * 4);
#pragma unroll
          for (int m = 0; m < 4; ++m) {
            rpk[m][n][0] = pk_bf16(sigmoidf_(acci[m][n][0] + ba[0]), sigmoidf_(acci[m][n][1] + ba[1]));
            rpk[m][n][1] = pk_bf16(sigmoidf_(acci[m][n][2] + ba[2]), sigmoidf_(acci[m][n][3] + ba[3]));
          }
        }
      }
    }
    u32x2 wla[4][4], wu[4][4];
#pragma unroll
    for (int n = 0; n < 4; ++n) {
      const int cl = wc * 64 + n * 16 + fq * 4;
      const int ch = ch0 + cl;
      const f32x4 bx = *(const f32x4*)(b_x + ch), lm = *(const f32x4*)(lam + ch);
      float sp[4];
#pragma unroll
      for (int j = 0; j < 4; ++j) sp[j] = -8.f * __logf(1.f + __expf(-lm[j]));
#pragma unroll
      for (int m = 0; m < 4; ++m) {
        const int rl = wr * 64 + m * 16 + fr;
        const int R = r0 + rl;
        const u32x2 xw = *(const u32x2*)(sA + (cl >> 6) * 16384 + swz(rl, (cl & 63) >> 3) + (fq & 1) * 8);
        const float xc[4] = {bflo(xw.x), bfhi(xw.x), bflo(xw.y), bfhi(xw.y)};
        float la[4], u[4];
#pragma unroll
        for (int j = 0; j < 4; ++j) {
          const float r = (j & 1) ? bfhi(rpk[m][n][j >> 1]) : bflo(rpk[m][n][j >> 1]);
          const float ig = sigmoidf_(acci[m][n][j] + bx[j]);
          la[j] = sp[j] * r;
          { const float x2 = 2.f * la[j]; const float om = x2 > -0.02f ? -x2 * (1.f + x2 * (0.5f + x2 * (1.f / 6.f))) : 1.f - __expf(x2); u[j] = __builtin_amdgcn_sqrtf(fmaxf(om, 0.f)) * ig * xc[j]; }
          if (R == T_) la[j] = -1e30f;
        }
        wla[m][n].x = pk_bf16(la[0], la[1]); wla[m][n].y = pk_bf16(la[2], la[3]);
        wu[m][n].x = pk_bf16(u[0], u[1]); wu[m][n].y = pk_bf16(u[2], u[3]);
      }
    }
    __syncthreads();
    wave_tile_store_bf16(wla, LA + (size_t)(r0 + wr * 64) * 1280 + ch0 + wc * 64, 1280, 32768);
    wave_tile_store_bf16(wu, U + (size_t)(r0 + wr * 64) * 1280 + ch0 + wc * 64, 1280, 32768);
  }
}

constexpr int NCHUNK = 257;
DEVI void scan_summaries(PP p) {
  const u16* LA = (const u16*)(p->ws + OFF_LA); const u16* U = (const u16*)(p->ws + OFF_U);
  float* SL = (float*)(p->ws + OFF_SUML); float* SH = (float*)(p->ws + OFF_SUMH);
  for (int item = bid_(); item < NCHUNK * 3; item += gdim_()) {
    const int c = item / 3, cgp = item - c * 3;
    const int ch = cgp * 512 + tid_() * 2;
    if (ch >= 1280) continue;
    const int R0 = c * 64, nr = min(64, M_ - R0);
    float s0 = 0.f, s1 = 0.f, h0 = 0.f, h1 = 0.f;
#pragma unroll 32
    for (int r = 0; r < nr; ++r) {
      const unsigned lw = *(const unsigned*)(LA + (size_t)(R0 + r) * 1280 + ch);
      const unsigned uw = *(const unsigned*)(U + (size_t)(R0 + r) * 1280 + ch);
      const float l0 = bflo(lw), l1 = bfhi(lw);
      h0 = __expf(l0) * h0 + bflo(uw); h1 = __expf(l1) * h1 + bfhi(uw);
      s0 += l0; s1 += l1;
    }
    *(float2*)(SL + c * 1280 + ch) = make_float2(s0, s1);
    *(float2*)(SH + c * 1280 + ch) = make_float2(h0, h1);
  }
}
DEVI void scan_final(PP p) {
  const u16* LA = (const u16*)(p->ws + OFF_LA); const u16* U = (const u16*)(p->ws + OFF_U);
  u16* G = (u16*)(p->ws + OFF_G);
  const float* SL = (const float*)(p->ws + OFF_SUML); const float* SH = (const float*)(p->ws + OFF_SUMH);
  for (int item = bid_(); item < NCHUNK * 3; item += gdim_()) {
    const int c = item / 3, cgp = item - c * 3;
    const int ch = cgp * 512 + tid_() * 2;
    if (ch >= 1280) continue;
    float h0 = 0.f, h1 = 0.f;
#pragma unroll 32
    for (int cc = 0; cc < c; ++cc) {
      const float2 sl = *(const float2*)(SL + cc * 1280 + ch), sh = *(const float2*)(SH + cc * 1280 + ch);
      h0 = __expf(sl.x) * h0 + sh.x; h1 = __expf(sl.y) * h1 + sh.y;
    }
    const int R0 = c * 64, nr = min(64, M_ - R0);
#pragma unroll 32
    for (int r = 0; r < nr; ++r) {
      const size_t o = (size_t)(R0 + r) * 1280 + ch;
      const unsigned lw = *(const unsigned*)(LA + o), uw = *(const unsigned*)(U + o), gw = *(const unsigned*)(G + o);
      h0 = __expf(bflo(lw)) * h0 + bflo(uw); h1 = __expf(bfhi(lw)) * h1 + bfhi(uw);
      *(unsigned*)(G + o) = pk_bf16(h0 * bflo(gw), h1 * bfhi(gw));
    }
  }
}

DEVI void ckv_norm(PP p, int l) {
  const int lane = tid_() & 63, wid = tid_() >> 6;
  const float* CRAW = (const float*)(p->ws + OFF_CRAW); u16* CKV = (u16*)(p->ws + OFF_CKV);
  const f32x4 g = *(const f32x4*)(p->in[12] + (size_t)l * 256 + lane * 4);
  for (int row = bid_() * 4 + wid; row < MP; row += gdim_() * 4) {
    const f32x4 v = *(const f32x4*)(CRAW + (size_t)row * 256 + lane * 4);
    const float ss = wave_sum(v[0] * v[0] + v[1] * v[1] + v[2] * v[2] + v[3] * v[3]);
    const float rs = rsqrtf(ss * (1.f / 256.f) + LN_EPS);
    u32x2 w; w.x = pk_bf16(v[0] * rs * g[0], v[1] * rs * g[1]); w.y = pk_bf16(v[2] * rs * g[2], v[3] * rs * g[3]);
    *(u32x2*)(CKV + (size_t)row * 256 + lane * 4) = w;
  }
}

DEVI int score_bin(float s) {
  const unsigned u = __float_as_uint(s);
  int mg = (int)((u >> 19) & 0xFFF) - 1520;
  mg = min(max(mg, 0), 1023);
  return (u >> 31) ? 1023 - mg : 1024 + mg;
}

constexpr int TK_CAP = 1024;
DEVI void idx_scores(const f32x16& acc, const float (&wv)[2][8], float (&sc)[2]) {
#pragma unroll
  for (int s = 0; s < 2; ++s) {
    float v = 0.f;
#pragma unroll
    for (int i = 0; i < 4; ++i)
#pragma unroll
      for (int bb = 0; bb < 2; ++bb) v = fmaf(wv[s][2 * i + bb], __int_as_float(max(__float_as_int(acc[4 * i + 2 * s + bb]), 0)), v);
    sc[s] = v;
  }
}

DEVI unsigned f2ord(float s) { const unsigned u = __float_as_uint(s); return u ^ ((unsigned)((int)u >> 31) | 0x80000000u); }
DEVI unsigned bin_lower_ord(int b) {
  if (b >= 1024) { const int mg = b - 1024; return mg == 0 ? 0x80000000u : (((unsigned)(mg + 1520) << 19) | 0x80000000u); }
  const int mg = 1023 - b;
  const unsigned bmax = mg == 1023 ? 0x7FFFFFFFu : (((unsigned)(mg + 1 + 1520) << 19) - 1u);
  return ~(0x80000000u | bmax);
}
DEVI void hist_search(const unsigned* hq, int lane, int Kt, int& bstar, int& nabove, int& total) {
  int sL = 0;
#pragma unroll
  for (int w = 0; w < 16; ++w) { const unsigned x = hq[1008 - 16 * lane + w]; sL += (int)(x & 0xffff) + (int)(x >> 16); }
  int P = sL;
#pragma unroll
  for (int o = 1; o < 64; o <<= 1) { const int y = __shfl_up(P, o); if (lane >= o) P += y; }
  total = __shfl(P, 63);
  const unsigned long long mk = __ballot(P >= Kt);
  if (mk == 0ull) { bstar = -1; nabove = total; return; }
  const int Ls = __ffsll((long long)mk) - 1;
  const int above0 = __shfl(P - sL, Ls);
  const int base_bin = 2047 - 32 * Ls;
  const int mybin = base_bin - (lane & 31);
  const int cntk = (int)((hq[mybin >> 1] >> ((mybin & 1) * 16)) & 0xffff);
  int Ck = cntk;
#pragma unroll
  for (int o = 1; o < 32; o <<= 1) { const int y = __shfl_up(Ck, o); if ((lane & 31) >= o) Ck += y; }
  const unsigned long long m2 = __ballot(lane < 32 && above0 + Ck >= Kt);
  const int ks = m2 ? (__ffsll((long long)m2) - 1) : 31;
  bstar = base_bin - ks;
  nabove = above0 + __shfl(Ck - cntk, ks);
}
DEVI void score4(const h16x8 (&qf)[2][4], const h16x8 (&kf)[4], const float (&wv)[2][2][8], float (&sc)[2][2]) {
#pragma unroll
  for (int rb = 0; rb < 2; ++rb) {
    f32x16 acc;
#pragma unroll
    for (int i = 0; i < 16; ++i) acc[i] = 0.f;
#pragma unroll
    for (int ks = 0; ks < 4; ++ks) acc = __builtin_amdgcn_mfma_f32_32x32x16_f16(qf[rb][ks], kf[ks], acc, 0, 0, 0);
    idx_scores(acc, wv[rb], sc[rb]);
  }
}

DEVI void topk_phase(PP p, unsigned char* smem) {
  const int tid = tid_(), lane = tid & 63, wid = tid >> 6;
  const _Float16* QI = (const _Float16*)(p->ws + OFF_QI); const _Float16* KI = (const _Float16*)(p->ws + OFF_KI);
  const float* WI = (const float*)(p->ws + OFF_WI); u16* SEL = (u16*)(p->ws + OFF_SEL);
  unsigned* hist = (unsigned*)smem;
  unsigned* cand_o = (unsigned*)smem;
  u16* cand_i = (u16*)(smem + 32768);
  unsigned* bm = (unsigned*)(smem + 49152);
  int* meta = (int*)(smem + 49152 + 8448);
  const int r = lane & 31, hi = lane >> 5;
  const int a_head = 2 * (r >> 3) + (r & 1), a_ql = 2 * ((r >> 2) & 1) + ((r >> 1) & 1);
  const int G = gdim_();
  for (int rnd = 0;; ++rnd) {
    const int j = rnd * G + ((rnd & 1) ? (G - 1 - bid_()) : bid_());
    if (j >= 2052) break;
    const int bb = j & 1, qt = 1025 - (j >> 1);
    const int t0 = qt * 8, Rb = bb * T_ + t0;
    const int nchunks = (t0 + 7) / 32 + 1;
    const bool small = (t0 + 8) <= TK_CAP;
    __syncthreads();
    for (int i = tid; i < 8192; i += 256) hist[i] = 0;
    for (int i = tid; i < 8 * 264; i += 256) bm[i] = 0;
    if (tid < 32) meta[tid] = 0;
    h16x8 qf[2][4]; float wv[2][2][8]; int tq[2][2];
#pragma unroll
    for (int rb = 0; rb < 2; ++rb) {
#pragma unroll
      for (int ks = 0; ks < 4; ++ks) qf[rb][ks] = *(const h16x8*)(QI + (size_t)(Rb + rb * 4 + a_ql) * 512 + a_head * 64 + ks * 16 + hi * 8);
#pragma unroll
      for (int s = 0; s < 2; ++s) {
        const int ql = rb * 4 + 2 * hi + s;
        tq[rb][s] = t0 + ql;
        const f32x4 w0 = *(const f32x4*)(WI + (size_t)(Rb + ql) * 8), w1 = *(const f32x4*)(WI + (size_t)(Rb + ql) * 8 + 4);
#pragma unroll
        for (int h = 0; h < 4; ++h) { wv[rb][s][h] = w0[h]; wv[rb][s][4 + h] = w1[h]; }
      }
    }
    const _Float16* kbase = KI + (size_t)(bb * T_ + r) * 64 + hi * 8;
    __syncthreads();
    if (!small) {
      h16x8 ks2[2][4];
      {
        const int c = min(16 * wid, nchunks - 1);
#pragma unroll
        for (int ks = 0; ks < 4; ++ks) ks2[0][ks] = *(const h16x8*)(kbase + (size_t)c * 2048 + ks * 16);
      }
#pragma unroll 1
      for (int cb = 16 * wid; cb < nchunks; cb += 128) {
#pragma unroll
        for (int u = 0; u < 2; ++u) {
          const int c = cb + 64 * u;
          const int cn = min(c + 64, nchunks - 1);
#pragma unroll
          for (int ks = 0; ks < 4; ++ks) ks2[u ^ 1][ks] = *(const h16x8*)(kbase + (size_t)cn * 2048 + ks * 16);
          float sc[2][2];
          score4(qf, ks2[u], wv, sc);
          const int key = c * 32 + r;
#pragma unroll
          for (int rb = 0; rb < 2; ++rb)
#pragma unroll
            for (int s = 0; s < 2; ++s)
              if (key <= tq[rb][s] && c < nchunks) { const int bin = score_bin(sc[rb][s]); atomicAdd(&hist[(rb * 4 + 2 * hi + s) * 1024 + (bin >> 1)], 1u << ((bin & 1) * 16)); }
        }
      }
      __syncthreads();
#pragma unroll 1
      for (int qq = 0; qq < 2; ++qq) {
        const int q8 = wid * 2 + qq, n = t0 + q8 + 1;
        int bstar, nabove, total;
        int ns = 0;
#pragma unroll
        for (int w = 0; w < 16; ++w) { const unsigned xw = hist[q8 * 1024 + 16 * lane + w]; ns += (int)(xw & 0xffff) + (int)(xw >> 16); }
#pragma unroll
        for (int o = 32; o > 0; o >>= 1) ns += __shfl_xor(ns, o);
        const float r0 = 256.f * (float)ns / (float)n;
        const int rs = (int)(r0 + 3.f * sqrtf(r0) + 9.f);
        hist_search(hist + q8 * 1024, lane, rs, bstar, nabove, total);
        if (lane == 0) meta[q8] = (int)(bstar < 0 ? 0u : bin_lower_ord(bstar));
      }
      __syncthreads();
    }
    {
      unsigned cutv[2][2];
#pragma unroll
      for (int rb = 0; rb < 2; ++rb)
#pragma unroll
        for (int s = 0; s < 2; ++s) cutv[rb][s] = (unsigned)meta[rb * 4 + 2 * hi + s];
      h16x8 kr[2][4];
      {
        const int c = min(wid, nchunks - 1);
#pragma unroll
        for (int ks = 0; ks < 4; ++ks) kr[0][ks] = *(const h16x8*)(kbase + (size_t)c * 2048 + ks * 16);
      }
#pragma unroll 1
      for (int cb = wid; cb < nchunks; cb += 8) {
#pragma unroll
        for (int u = 0; u < 2; ++u) {
          const int c = cb + 4 * u;
          const int cn = min(c + 4, nchunks - 1);
#pragma unroll
          for (int ks = 0; ks < 4; ++ks) kr[u ^ 1][ks] = *(const h16x8*)(kbase + (size_t)cn * 2048 + ks * 16);
          float sc[2][2];
          score4(qf, kr[u], wv, sc);
          const int key = c * 32 + r;
#pragma unroll
          for (int rb = 0; rb < 2; ++rb)
#pragma unroll
            for (int s = 0; s < 2; ++s) {
              const unsigned od = f2ord(sc[rb][s]);
              if (key <= tq[rb][s] && c < nchunks && od >= cutv[rb][s]) {
                const int q8 = rb * 4 + 2 * hi + s;
                const int pos = atomicAdd(&meta[24 + q8], 1);
                if (pos < TK_CAP) { cand_o[q8 * TK_CAP + pos] = od; cand_i[q8 * TK_CAP + pos] = (u16)key; }
              }
            }
        }
      }
    }
    __syncthreads();
    if (tid < 8) { const int C = meta[24 + tid], keff = min(256, t0 + tid + 1); if (C < keff || C > TK_CAP) atomicOr(&meta[16], 1); }
    __syncthreads();
    const int fb = meta[16];
    if (!fb) {
#pragma unroll 1
      for (int qq = 0; qq < 2; ++qq) {
        const int q8 = wid * 2 + qq, C = meta[24 + q8], keff = min(256, t0 + q8 + 1);
        const unsigned* co = cand_o + q8 * TK_CAP; const u16* ci = cand_i + q8 * TK_CAP;
        if (C <= keff) {
          for (int i = lane; i < C; i += 64) { const int ii = ci[i]; atomicOr(&bm[q8 * 264 + (ii >> 5)], 1u << (ii & 31)); }
        } else {
          unsigned ov[16];
#pragma unroll
          for (int u = 0; u < 16; ++u) { const int i = u * 64 + lane; ov[u] = i < C ? co[i] : 0u; }
          unsigned T = 0u;
#pragma unroll 1
          for (int bit = 31; bit >= 0; --bit) {
            const unsigned trial = T | (1u << bit);
            int cnt = 0;
#pragma unroll
            for (int u = 0; u < 16; ++u) cnt += __popcll(__ballot(ov[u] >= trial));
            if (cnt >= keff) T = trial;
          }
          int ngt = 0;
#pragma unroll
          for (int u = 0; u < 16; ++u) ngt += __popcll(__ballot(ov[u] > T));
          const int need = keff - ngt;
#pragma unroll
          for (int u = 0; u < 16; ++u) {
            const int i = u * 64 + lane;
            if (i < C && ov[u] > T) { const int ii = ci[i]; atomicOr(&bm[q8 * 264 + (ii >> 5)], 1u << (ii & 31)); }
          }
          int lastkey = -1;
#pragma unroll 1
          for (int ts = 0; ts < need; ++ts) {
            int best = 0x7fffffff;
#pragma unroll
            for (int u = 0; u < 16; ++u) {
              const int i = u * 64 + lane;
              if (i < C && ov[u] == T) { const int k = ci[i]; if (k > lastkey && k < best) best = k; }
            }
#pragma unroll
            for (int o = 32; o > 0; o >>= 1) best = min(best, __shfl_xor(best, o));
            if (best == 0x7fffffff) break;
            if (lane == 0) atomicOr(&bm[q8 * 264 + (best >> 5)], 1u << (best & 31));
            lastkey = best;
          }
        }
      }
    } else {
      __syncthreads();
      for (int i = tid; i < 8192; i += 256) hist[i] = 0;
      if (tid < 32) meta[tid] = 0;
      __syncthreads();
#pragma unroll 1
      for (int pass = 0; pass < 2; ++pass) {
        int bst[2][2];
        if (pass) {
#pragma unroll
          for (int rb = 0; rb < 2; ++rb)
#pragma unroll
            for (int s = 0; s < 2; ++s) bst[rb][s] = meta[rb * 4 + 2 * hi + s];
        }
#pragma unroll 1
        for (int c = wid; c < nchunks; c += 4) {
          h16x8 kf[4];
#pragma unroll
          for (int ks = 0; ks < 4; ++ks) kf[ks] = *(const h16x8*)(kbase + (size_t)c * 2048 + ks * 16);
          float sc[2][2];
          score4(qf, kf, wv, sc);
          const int key = c * 32 + r;
#pragma unroll
          for (int rb = 0; rb < 2; ++rb)
#pragma unroll
            for (int s = 0; s < 2; ++s) {
              if (key <= tq[rb][s]) {
                const int q8 = rb * 4 + 2 * hi + s;
                const int bin = score_bin(sc[rb][s]);
                if (!pass) {
                  atomicAdd(&hist[q8 * 1024 + (bin >> 1)], 1u << ((bin & 1) * 16));
                } else {
                  if (bin > bst[rb][s]) atomicOr(&bm[q8 * 264 + (key >> 5)], 1u << (key & 31));
                  else if (bin == bst[rb][s]) { const int pos = atomicAdd(&meta[24 + q8], 1); if (pos < TK_CAP) { cand_o[q8 * TK_CAP + pos] = f2ord(sc[rb][s]); cand_i[q8 * TK_CAP + pos] = (u16)key; } }
                }
              }
            }
        }
        __syncthreads();
        if (!pass) {
          int bres[2], ares[2];
#pragma unroll
          for (int qq = 0; qq < 2; ++qq) {
            const int q8 = wid * 2 + qq, nvalid = t0 + q8 + 1;
            int bstar = -1, nabove = nvalid, total;
            if (nvalid > 256) hist_search(hist + q8 * 1024, lane, 256, bstar, nabove, total);
            bres[qq] = bstar; ares[qq] = nabove;
          }
          __syncthreads();
          if (lane == 0) { meta[wid * 2] = bres[0]; meta[wid * 2 + 1] = bres[1]; meta[8 + wid * 2] = ares[0]; meta[8 + wid * 2 + 1] = ares[1]; }
          __syncthreads();
        }
      }
#pragma unroll 1
      for (int qq = 0; qq < 2; ++qq) {
        const int q8 = wid * 2 + qq, nvalid = t0 + q8 + 1;
        if (nvalid > 256) {
          const int need = 256 - meta[8 + q8];
          const int cn = min(meta[24 + q8], TK_CAP);
          const unsigned* co = cand_o + q8 * TK_CAP; const u16* ci = cand_i + q8 * TK_CAP;
          for (int i = lane; i < cn; i += 64) {
            const unsigned oi = co[i]; const int ii = ci[i];
            int rank = 0;
            for (int k = 0; k < cn; ++k) { const unsigned ok = co[k]; const int ik = ci[k]; rank += (ok > oi || (ok == oi && ik < ii)) ? 1 : 0; }
            if (rank < need) atomicOr(&bm[q8 * 264 + (ii >> 5)], 1u << (ii & 31));
          }
        }
      }
    }
    __syncthreads();
#pragma unroll 1
    for (int qq = 0; qq < 2; ++qq) {
      const int q8 = wid * 2 + qq;
      u16* srow = SEL + (size_t)(Rb + q8) * 256;
      unsigned wds[5]; int cnt = 0;
#pragma unroll
      for (int i = 0; i < 5; ++i) { const int idx = 5 * lane + i; wds[i] = idx < 257 ? bm[q8 * 264 + idx] : 0u; cnt += __popc(wds[i]); }
      int P = cnt;
#pragma unroll
      for (int o = 1; o < 64; o <<= 1) { const int y = __shfl_up(P, o); if (lane >= o) P += y; }
      const int total = __shfl(P, 63);
      int pos = P - cnt;
#pragma unroll
      for (int i = 0; i < 5; ++i) {
        unsigned w = wds[i];
        while (w) { const int b = __ffs((int)w) - 1; if (pos < 256) srow[pos] = (u16)((5 * lane + i) * 32 + b); ++pos; w &= w - 1; }
      }
      for (int pp = total + lane; pp < 256; pp += 64) srow[pp] = (u16)0xFFFF;
    }
  }
}

#define TR8(d0, d1, d2, d3, d4, d5, d6, d7, a0, a1)                                                                   \
  asm volatile("ds_read_b64_tr_b16 %0, %8\n\tds_read_b64_tr_b16 %1, %9\n\t"                                         \
               "ds_read_b64_tr_b16 %2, %8 offset:32\n\tds_read_b64_tr_b16 %3, %9 offset:32\n\t"                     \
               "ds_read_b64_tr_b16 %4, %8 offset:64\n\tds_read_b64_tr_b16 %5, %9 offset:64\n\t"                     \
               "ds_read_b64_tr_b16 %6, %8 offset:96\n\tds_read_b64_tr_b16 %7, %9 offset:96\n\ts_waitcnt lgkmcnt(0)" \
               : "=&v"(d0), "=&v"(d1), "=&v"(d2), "=&v"(d3), "=&v"(d4), "=&v"(d5), "=&v"(d6), "=&v"(d7)              \
               : "v"(a0), "v"(a1)                                                                                     \
               : "memory")

DEVI void attn_phase(PP p, int l, unsigned char* smem, bool dummy = false) {
  const int tid = tid_(), lane = tid & 63, wid = tid >> 6, fr = lane & 15, fq = lane >> 4;
  u16* QA = (u16*)(p->ws + OFF_QA); const u16* CKV = (const u16*)(p->ws + OFF_CKV); const u16* SEL = (const u16*)(p->ws + OFF_SEL);
  unsigned char* buf = smem + wid * 17408;
  float gm;
  { const f32x4 g = *(const f32x4*)(p->in[12] + (size_t)l * 256 + lane * 4);
    gm = wave_max(fmaxf(fmaxf(fabsf(g[0]), fabsf(g[1])), fmaxf(fabsf(g[2]), fabsf(g[3])))); }
  const float cmax = 16.f * gm * 1.01f;
  const unsigned lbase = (unsigned)(uintptr_t)buf;
  const unsigned tr_a0 = lbase + (4 * fq + (fr >> 2)) * 544 + (fr & 3) * 8;
  const unsigned tr_a1 = tr_a0 + 16 * 544;
  const int Gd = gdim_(), bidx = bid_();
  const bool part_ok = (Gd & 7) == 0;
  const int part = bidx & 7, g0 = part_ok ? (bidx >> 3) : bidx, gstep = part_ok ? (Gd >> 3) : Gd, gend = part_ok ? 513 : M_ / 4;
  const int gslot = lane >> 3, gch = lane & 7;
  for (int grp = g0; grp < gend; grp += gstep) {
    const int R = part_ok ? ((part & 1) * T_ + (part >> 1) * 2052 + grp * 4 + wid) : grp * 4 + wid;
    const int bb = R >= T_ ? 1 : 0, t = R - bb * T_;
    const int keff = min(256, t + 1);
    const u16* cbase = CKV + (size_t)bb * T_ * 256 + gch * 8;
    const u16* selr = SEL + (size_t)R * 256 + gslot;
    s16x8 qf[8];
    {
#pragma unroll
      for (int i = 0; i < 4; ++i) {
        const int pp = lane + 64 * i, hd = pp >> 5, chn = pp & 31;
        *(u32x4*)(buf + hd * 528 + chn * 16) = *(const u32x4*)(QA + (size_t)R * 2048 + hd * 256 + chn * 8);
      }
#pragma unroll
      for (int ks = 0; ks < 8; ++ks) {
        qf[ks] = (s16x8){0, 0, 0, 0, 0, 0, 0, 0};
        if (fr < 8) qf[ks] = *(const s16x8*)(buf + fr * 528 + (ks * 4 + fq) * 16);
      }
    }
    unsigned ix[4];
#pragma unroll
    for (int i = 0; i < 4; ++i) ix[i] = selr[8 * i];
    s16x8 g[16];
#pragma unroll
    for (int i = 0; i < 4; ++i) {
      const u16* pr = cbase + (size_t)(ix[i] == 0xFFFFu ? 0u : ix[i]) * 256;
#pragma unroll
      for (int j = 0; j < 4; ++j) g[4 * i + j] = *(const s16x8*)(pr + j * 64);
    }
#pragma unroll
    for (int i = 0; i < 4; ++i) ix[i] = selr[32 + 8 * i];
    float nq = 0.f;
#pragma unroll
    for (int ks = 0; ks < 8; ++ks)
#pragma unroll
      for (int e = 0; e < 8; ++e) { const float x = bf2f((u16)qf[ks][e]); nq = fmaf(x, x, nq); }
    nq += __shfl_xor(nq, 16); nq += __shfl_xor(nq, 32);
    const float mb = ATT_SCALE * sqrtf(nq) * cmax;
    f32x4 o[16];
#pragma unroll
    for (int d = 0; d < 16; ++d) o[d] = (f32x4){0.f, 0.f, 0.f, 0.f};
    float lsum = 0.f;
#pragma unroll 1
    for (int c = 0; c < 8; ++c) {
#pragma unroll
      for (int i = 0; i < 4; ++i)
#pragma unroll
        for (int j = 0; j < 4; ++j) *(s16x8*)(buf + (gslot + 8 * i) * 544 + (gch + 8 * j) * 16) = g[4 * i + j];
      {
#pragma unroll
        for (int i = 0; i < 4; ++i) {
          const u16* pr = cbase + (size_t)(ix[i] == 0xFFFFu ? 0u : ix[i]) * 256;
#pragma unroll
          for (int j = 0; j < 4; ++j) g[4 * i + j] = *(const s16x8*)(pr + j * 64);
        }
        const int c2 = min(c + 2, 7);
#pragma unroll
        for (int i = 0; i < 4; ++i) ix[i] = selr[c2 * 32 + 8 * i];
      }
      f32x4 sa = {0.f, 0.f, 0.f, 0.f}, sb = {0.f, 0.f, 0.f, 0.f};
#pragma unroll
      for (int ks = 0; ks < 8; ++ks) {
        const s16x8 fa = *(const s16x8*)(buf + fr * 544 + (ks * 4 + fq) * 16);
        const s16x8 fb = *(const s16x8*)(buf + (16 + fr) * 544 + (ks * 4 + fq) * 16);
        sa = __builtin_amdgcn_mfma_f32_16x16x32_bf16(fa, qf[ks], sa, 0, 0, 0);
        sb = __builtin_amdgcn_mfma_f32_16x16x32_bf16(fb, qf[ks], sb, 0, 0, 0);
      }
      float pa_[4], pb_[4];
#pragma unroll
      for (int jj = 0; jj < 4; ++jj) {
        const int posa = c * 32 + 4 * fq + jj;
        pa_[jj] = posa < keff ? __expf(sa[jj] * ATT_SCALE - mb) : 0.f;
        pb_[jj] = posa + 16 < keff ? __expf(sb[jj] * ATT_SCALE - mb) : 0.f;
        lsum += pa_[jj] + pb_[jj];
      }
      union { u32x4 u; s16x8 s; } pf;
      pf.u[0] = pk_bf16(pa_[0], pa_[1]); pf.u[1] = pk_bf16(pa_[2], pa_[3]); pf.u[2] = pk_bf16(pb_[0], pb_[1]); pf.u[3] = pk_bf16(pb_[2], pb_[3]);
      asm volatile("s_waitcnt lgkmcnt(0)" ::: "memory");
      {
        u32x2 e[1][8];
#define TRI(g_, E) asm volatile("ds_read_b64_tr_b16 %0, %8\n\tds_read_b64_tr_b16 %1, %9\n\t" \
               "ds_read_b64_tr_b16 %2, %8 offset:32\n\tds_read_b64_tr_b16 %3, %9 offset:32\n\t" \
               "ds_read_b64_tr_b16 %4, %8 offset:64\n\tds_read_b64_tr_b16 %5, %9 offset:64\n\t" \
               "ds_read_b64_tr_b16 %6, %8 offset:96\n\tds_read_b64_tr_b16 %7, %9 offset:96" \
               : "=&v"(E[0]), "=&v"(E[1]), "=&v"(E[2]), "=&v"(E[3]), "=&v"(E[4]), "=&v"(E[5]), "=&v"(E[6]), "=&v"(E[7]) \
               : "v"(tr_a0 + (g_) * 128), "v"(tr_a1 + (g_) * 128) : "memory")
#define TRW(N, E) asm volatile("s_waitcnt lgkmcnt(" #N ")" : "+v"(E[0]), "+v"(E[1]), "+v"(E[2]), "+v"(E[3]), "+v"(E[4]), "+v"(E[5]), "+v"(E[6]), "+v"(E[7]) :: "memory")
#define PVM(g_, E) { union { u32x4 u; s16x8 s; } c0, c1, c2, c3; \
          c0.u = (u32x4){E[0].x, E[0].y, E[1].x, E[1].y}; c1.u = (u32x4){E[2].x, E[2].y, E[3].x, E[3].y}; \
          c2.u = (u32x4){E[4].x, E[4].y, E[5].x, E[5].y}; c3.u = (u32x4){E[6].x, E[6].y, E[7].x, E[7].y}; \
          o[(g_) * 4 + 0] = __builtin_amdgcn_mfma_f32_16x16x32_bf16(c0.s, pf.s, o[(g_) * 4 + 0], 0, 0, 0); \
          o[(g_) * 4 + 1] = __builtin_amdgcn_mfma_f32_16x16x32_bf16(c1.s, pf.s, o[(g_) * 4 + 1], 0, 0, 0); \
          o[(g_) * 4 + 2] = __builtin_amdgcn_mfma_f32_16x16x32_bf16(c2.s, pf.s, o[(g_) * 4 + 2], 0, 0, 0); \
          o[(g_) * 4 + 3] = __builtin_amdgcn_mfma_f32_16x16x32_bf16(c3.s, pf.s, o[(g_) * 4 + 3], 0, 0, 0); }
        TRI(0, e[0]); TRW(0, e[0]); PVM(0, e[0]);
        TRI(1, e[0]); TRW(0, e[0]); PVM(1, e[0]);
        TRI(2, e[0]); TRW(0, e[0]); PVM(2, e[0]);
        TRI(3, e[0]); TRW(0, e[0]); PVM(3, e[0]);
#undef TRI
#undef TRW
#undef PVM
      }
    }
    lsum += __shfl_xor(lsum, 16); lsum += __shfl_xor(lsum, 32);
    const float inv = 1.f / lsum;
    if (fr < 8) {
#pragma unroll
      for (int d = 0; d < 16; ++d) {
        u32x2 w; w.x = pk_bf16(o[d][0] * inv, o[d][1] * inv); w.y = pk_bf16(o[d][2] * inv, o[d][3] * inv);
        *(u32x2*)(buf + fr * 528 + d * 32 + fq * 8) = w;
      }
    }
    {
      u16* orow = dummy ? (u16*)p->out + (size_t)(R < 16384 ? R : 0) * 2048 : QA + (size_t)R * 2048;
#pragma unroll
      for (int i = 0; i < 4; ++i) {
        const int pp = lane + 64 * i, hd = pp >> 5, chn = pp & 31;
        const u32x4 q = *(const u32x4*)(buf + hd * 528 + chn * 16);
        *(u32x4*)(orow + hd * 256 + chn * 8) = q;
      }
    }
  }
}

DEVI void merge_phase(PP p, unsigned char* smem) {
  EPI_IDX
  unsigned char* ws = p->ws;
  const u16* XB = (const u16*)(ws + OFF_R1); const u16* HG = (const u16*)(ws + OFF_G); const u16* OL = (const u16*)(ws + OFF_QA);
  const u16* WG = (const u16*)(ws + OFF_WG); const u16* WBA = (const u16*)(ws + OFF_WBA); const u16* WOB = (const u16*)(ws + OFF_WOB);
  u16* MIX = (u16*)(ws + OFF_MIX);
  TileIter ti; ti.init(8);
  int mt, nt;
  while (ti.next(mt, nt)) {
    f32x4 acc[4][4];
    unsigned sg[4][4][2];
#pragma unroll 1
    for (int br = 0; br < 2; ++br) {
      zero_acc(acc);
      gemm_kloop(XB + (size_t)mt * 128 * 1024, 1024, WG + (size_t)(br * 1024 + nt * 128) * 1024, 1024, 1024, acc, smem);
#pragma unroll
      for (int m = 0; m < 4; ++m)
#pragma unroll
        for (int n = 0; n < 4; ++n) { sg[m][n][0] = pk_bf16(sigmoidf_(acc[m][n][0]), sigmoidf_(acc[m][n][1])); sg[m][n][1] = pk_bf16(sigmoidf_(acc[m][n][2]), sigmoidf_(acc[m][n][3])); }
      zero_acc(acc);
      if (br == 0) gemm_kloop(HG + (size_t)mt * 128 * 1280, 1280, WBA + (size_t)nt * 128 * 1280, 1280, 1280, acc, smem);
      else gemm_kloop(OL + (size_t)mt * 128 * 2048, 2048, WOB + (size_t)nt * 128 * 2048, 2048, 2048, acc, smem);
#pragma unroll
      for (int m = 0; m < 4; ++m) {
        const size_t row = (size_t)(mt * 128 + wr * 64 + m * 16 + fr);
#pragma unroll
        for (int n = 0; n < 4; ++n) {
          u16* ptr = MIX + row * 1024 + nt * 128 + wc * 64 + n * 16 + fq * 4;
          const f32x4 sgm = {bflo(sg[m][n][0]), bfhi(sg[m][n][0]), bflo(sg[m][n][1]), bfhi(sg[m][n][1])};
          f32x4 v = sgm * acc[m][n];
          if (br == 1) { const u32x2 pv = *(const u32x2*)ptr; v = v + (f32x4){bflo(pv.x), bfhi(pv.x), bflo(pv.y), bfhi(pv.y)}; }
          u32x2 w; w.x = pk_bf16(v[0], v[1]); w.y = pk_bf16(v[2], v[3]);
          *(u32x2*)ptr = w;
        }
      }
    }
  }
}

#define PH_PRE PP p = kparams(); unsigned char* ws = p->ws; unsigned char* smem = g_smem; const int l = __builtin_amdgcn_readfirstlane(l_); (void)l; (void)ws; (void)smem; u16* R1 = (u16*)(ws + OFF_R1); (void)R1;
NOINL void ph_pro(int l_) { PH_PRE ln_input(p); convert_weights(p, 0, smem); }
NOINL void ph_k0(int l_) { PH_PRE EpiA1 e{(u16*)(ws + OFF_XL), (u16*)(ws + OFF_G)}; gemm_phase_big(R1, 1024, (const u16*)(ws + OFF_W1), 1024, 1024, 20, e, smem); }
NOINL void ph_k1(int l_) { PH_PRE gates_phase(p, l, smem); }
NOINL void ph_k2(int l_) { PH_PRE scan_summaries(p); }
NOINL void ph_k3(int l_) { PH_PRE scan_final(p); }
NOINL void ph_k4(int l_) { PH_PRE EpiB1 e{(u16*)(ws + OFF_QA), (float*)(ws + OFF_CRAW), (_Float16*)(ws + OFF_QI), (_Float16*)(ws + OFF_KI), (float*)(ws + OFF_WI)};
  gemm_phase_big(R1, 1024, (const u16*)(ws + OFF_W1) + (size_t)2560 * 1024, 1024, 1024, 23, e, smem); }
NOINL void ph_k5(int l_) { PH_PRE ckv_norm(p, l); topk_phase(p, smem); }
NOINL void ph_k6(int l_) { PH_PRE attn_phase(p, l, smem); }
NOINL void ph_k7(int l_) { PH_PRE merge_phase(p, smem); }
NOINL void ph_k8(int l_) { PH_PRE EpiRes e{R1, nullptr}; gemm_phase((const u16*)(ws + OFF_MIX), 1024, (const u16*)(ws + OFF_WO), 1024, 1024, 8, e, smem); }
NOINL void ph_k9(int l_) { PH_PRE ln_rows_inplace(R1, p->in[18] + (size_t)l * 1024, p->in[19] + (size_t)l * 1024, nullptr); }
NOINL void ph_k10(int l_) { PH_PRE EpiUp e{(u16*)(ws + OFF_H), p->in[21] + (size_t)l * 4096}; gemm_phase_big(R1, 1024, (const u16*)(ws + OFF_WUP), 1024, 1024, 32, e, smem); }
NOINL void ph_k11(int l_) { PH_PRE EpiRes e{R1, p->in[23] + (size_t)l * 1024}; gemm_phase((const u16*)(ws + OFF_H), 4096, (const u16*)(ws + OFF_WDN), 4096, 4096, 8, e, smem); }
NOINL void ph_k12(int l_) { PH_PRE ln_rows_inplace(R1, p->in[24] + (size_t)l * 1024, p->in[25] + (size_t)l * 1024, l == 1 ? p->out : nullptr);
  if (l == 0) convert_weights(p, 1, smem); }

#ifndef PROBE_K
#define PROBE_K -1
#endif
DEVI void run_phase(int ph) {
  if (ph == 0) { ph_pro(0); return; }
  const int l = (ph - 1) / NPH_LAYER, k = (ph - 1) % NPH_LAYER;
  if (k == PROBE_K) {
    if (PROBE_K == 10) ph_k10(l);
    if (PROBE_K == 5) ph_k5(l);
    if (PROBE_K == 1) ph_k1(l);
    if (PROBE_K == 2) ph_k2(l);
    if (PROBE_K == 7) ph_k7(l);
    if (PROBE_K == 0) ph_k0(l);
    if (PROBE_K == 6) { PP p = kparams(); attn_phase(p, l, g_smem, true); }
  }
  switch (k) {
    case 0: ph_k0(l); break;
    case 1: ph_k1(l); break;
    case 2: ph_k2(l); break;
    case 3: ph_k3(l); break;
    case 4: ph_k4(l); break;
    case 5: ph_k5(l); break;
    case 6: ph_k6(l); break;
    case 7: ph_k7(l); break;
    case 8: ph_k8(l); break;
    case 9: ph_k9(l); break;
    case 10: ph_k10(l); break;
    case 11: ph_k11(l); break;
    case 12: ph_k12(l); break;
  }
}

__global__ void __launch_bounds__(256, 2) mega_fwd(Params p, int ph_lo, int ph_hi) {
  __shared__ uint4 xb_words;
  cg::grid_group grid = cg::this_grid();
  if (threadIdx.x == 0) xb_words = make_uint4(0u, 0u, 0u, 0u);
  __syncthreads();
  XcdBarrier xb = xcd_barrier_post((unsigned*)(p.ws + OFF_BAR), (volatile LAS unsigned*)&xb_words);
  if (ph_hi < 0) grid.sync();
  for (int ph = ph_lo; ph < ph_hi; ++ph) {
    if (ph > ph_lo) xcd_barrier(xb);
    run_phase(ph);
  }
}

extern "C" void kernel_launch(void* const* d_in, const int* in_sizes, int n_in, void* d_out, int out_size, void* d_ws, size_t ws_size,
                              hipStream_t stream) {
  static int grid_blocks = 0;
  if (!grid_blocks) {
    int dev = 0, cus = 0, per_cu = 0;
    hipGetDevice(&dev);
    hipDeviceGetAttribute(&cus, hipDeviceAttributeMultiprocessorCount, dev);
    hipOccupancyMaxActiveBlocksPerMultiprocessor(&per_cu, mega_fwd, 256, 0);
    if (per_cu < 1) per_cu = 1;
    if (per_cu > 2) per_cu = 2;
    grid_blocks = cus * per_cu;
    if (ws_size < WS_NEED) fprintf(stderr, "kernel_launch: workspace too small: %zu < %zu\n", ws_size, (size_t)WS_NEED);
  }
  if (n_in != 26 || ws_size < WS_NEED) return;
  Params p{};
  for (int i = 0; i < 26; ++i) p.in[i] = (const float*)d_in[i];
  p.out = (float*)d_out;
  p.ws = (unsigned char*)d_ws;
  (void)hipMemsetAsync((unsigned char*)d_ws + OFF_BAR, 0, 16384, stream);
#if MK_PER_PHASE
  for (int ph = 0; ph < NPHASES; ++ph) {
    int lo = ph, hi = ph + 1;
    void* args[] = {&p, &lo, &hi};
    hipLaunchCooperativeKernel((void*)mega_fwd, dim3(grid_blocks), dim3(256), args, 0, stream);
  }
#else
  int lo = 0, hi = NPHASES;
  void* args[] = {&p, &lo, &hi};
  hipError_t e = hipLaunchCooperativeKernel((void*)mega_fwd, dim3(grid_blocks), dim3(256), args, 0, stream);
  if (e != hipSuccess) fprintf(stderr, "cooperative launch failed: %s (grid %d)\n", hipGetErrorString(e), grid_blocks);
#endif
}
```
